# Optimizing an MI355X kernel written in HIP

```python
import jax, jax.numpy as jnp
from jax import lax
import numpy as np

D_MODEL = 1024
BATCH = 32
SEQ = 256
DEPTH = 2
DEC_BATCH = 8
DEC_SEQ = 4096
PAST_LEN = 256

GRID_W = 64
N_MIXERS = 2
N_MLA_LAYERS = (DEPTH + 1) // 2
N_NA_LAYERS = DEPTH // 2
MLA_HEADS = 16
Q_LORA_RANK = 256
KV_LORA_RANK = 128
QK_NOPE_DIM = 128
QK_ROPE_DIM = 64
V_HEAD_DIM = 128
MLA_WIDTH = MLA_HEADS * V_HEAD_DIM
MLA_SCALE = (QK_NOPE_DIM + QK_ROPE_DIM) ** -0.5
ROPE_AXIS_FREQS = QK_ROPE_DIM // 4
ROPE_THETA = 10000.0
Q_BLOCK = 128
NA_HEADS = 16
NA_HEAD_DIM = 64
NA_WIDTH = NA_HEADS * NA_HEAD_DIM
NA_MAX_ROWS = 8
NA_COLS = 16
NA_SCALE = NA_HEAD_DIM ** -0.5
EPS = 1e-6

kernel_name = "hybrid_mla_natten_dit_step"


def rms_norm(x, g):
    xf = x.astype(jnp.float32)
    y = xf * lax.rsqrt(jnp.mean(xf * xf, axis=-1, keepdims=True) + EPS)
    return (y * g.astype(jnp.float32)).astype(x.dtype)


def modulation(cond, w, b):
    return jnp.split(jax.nn.silu(cond) @ w + b, 3, axis=-1)


def softmax_f32(s):
    return jax.nn.softmax(s.astype(jnp.float32), axis=-1)


def grid_rope_tables(n):
    t = jnp.arange(n)
    pos = jnp.stack([t // GRID_W, t % GRID_W], axis=-1).astype(jnp.float32)
    inv = ROPE_THETA ** (-jnp.arange(ROPE_AXIS_FREQS, dtype=jnp.float32) / ROPE_AXIS_FREQS)
    ang = pos[:, :, None] * inv
    return jnp.cos(ang), jnp.sin(ang)


def axial_rope(x, cos, sin):
    xs = x.reshape(x.shape[:-1] + (2, 2, ROPE_AXIS_FREQS))
    x1, x2 = xs[..., 0, :], xs[..., 1, :]
    out = jnp.stack([x1 * cos - x2 * sin, x2 * cos + x1 * sin], axis=-2)
    return out.reshape(x.shape).astype(x.dtype)


def mla_project(h, w_in, q_norm_g, w_qb, kv_norm_g):
    splits = [Q_LORA_RANK, Q_LORA_RANK + KV_LORA_RANK, Q_LORA_RANK + KV_LORA_RANK + QK_ROPE_DIM]
    q_a, kv_a, k_rope, gate = jnp.split(h @ w_in, splits, axis=-1)
    q = (rms_norm(q_a, q_norm_g) @ w_qb).reshape(h.shape[:2] + (MLA_HEADS, QK_NOPE_DIM + QK_ROPE_DIM))
    c_kv = rms_norm(kv_a, kv_norm_g)
    return q[..., :QK_NOPE_DIM], q[..., QK_NOPE_DIM:], c_kv, k_rope, gate


def mla_expand(c_kv, w_kvb):
    kv = (c_kv @ w_kvb).reshape(c_kv.shape[:2] + (MLA_HEADS, QK_NOPE_DIM + V_HEAD_DIM))
    return kv[..., :QK_NOPE_DIM], kv[..., QK_NOPE_DIM:]


def mla_attend(q_nope, q_rope, k_nope, k_rope, v):
    s = (jnp.einsum('bqhd,bkhd->bhqk', q_nope, k_nope)
         + jnp.einsum('bqhr,bkr->bhqk', q_rope, k_rope)) * MLA_SCALE
    p = softmax_f32(s).astype(v.dtype)
    return jnp.einsum('bhqk,bkhd->bqhd', p, v)


def mla_output(o, gate, w_out):
    b, n = o.shape[:2]
    return (o.reshape(b, n, MLA_WIDTH) * jax.nn.silu(gate)) @ w_out


def mla_context(h, w_in, q_norm_g, w_qb, kv_norm_g, w_kvb, w_out):
    q_nope, q_rope, c_kv, k_rope, gate = mla_project(h, w_in, q_norm_g, w_qb, kv_norm_g)
    k_nope, v = mla_expand(c_kv, w_kvb)
    o = mla_attend(q_nope, q_rope, k_nope, k_rope, v)
    return mla_output(o, gate, w_out), c_kv, k_rope


def mla_latent(h, ckv_ctx, krope_ctx, w_in, q_norm_g, w_qb, kv_norm_g, w_kvb, w_out):
    b, n, _ = h.shape
    q_nope, q_rope, c_kv, k_rope, gate = mla_project(h, w_in, q_norm_g, w_qb, kv_norm_g)
    cos, sin = grid_rope_tables(n)
    q_rope = axial_rope(q_rope, cos[:, None], sin[:, None])
    k_rope = axial_rope(k_rope, cos, sin)
    k_nope, v = mla_expand(jnp.concatenate([ckv_ctx, c_kv], axis=1), w_kvb)
    k_rope_all = jnp.concatenate([krope_ctx, k_rope], axis=1)
    nb = n // Q_BLOCK
    qn_b = q_nope.reshape(b, nb, Q_BLOCK, MLA_HEADS, QK_NOPE_DIM).transpose(1, 0, 2, 3, 4)
    qr_b = q_rope.reshape(b, nb, Q_BLOCK, MLA_HEADS, QK_ROPE_DIM).transpose(1, 0, 2, 3, 4)
    o = lax.map(lambda qs: mla_attend(qs[0], qs[1], k_nope, k_rope_all, v), (qn_b, qr_b))
    o = o.transpose(1, 0, 2, 3, 4).reshape(b, n, MLA_HEADS, V_HEAD_DIM)
    return mla_output(o, gate, w_out)


def na_project(h, w_in):
    q, k, v, gate = jnp.split(h @ w_in, 4, axis=-1)
    shp = h.shape[:2] + (NA_HEADS, NA_HEAD_DIM)
    return q.reshape(shp), k.reshape(shp), v.reshape(shp), gate


def na_context(h, w_in, w_out):
    b, n, _ = h.shape
    q, k, v, gate = na_project(h, w_in)
    p = softmax_f32(jnp.einsum('bqhd,bkhd->bhqk', q, k) * NA_SCALE).astype(v.dtype)
    o = jnp.einsum('bhqk,bkhd->bqhd', p, v).reshape(b, n, NA_WIDTH)
    return (o * jax.nn.silu(gate)) @ w_out, k, v


def na_latent(h, k_ctx, v_ctx, w_in, rel_bias, w_out):
    b, n, _ = h.shape
    rows = n // GRID_W
    kr = min(NA_MAX_ROWS, rows)
    n_loc = kr * GRID_W
    q, k, v, gate = na_project(h, w_in)
    grid_shape = (b, rows, GRID_W, NA_HEADS, NA_HEAD_DIM)
    qg, kg, vg = q.reshape(grid_shape), k.reshape(grid_shape), v.reshape(grid_shape)
    cols = jnp.arange(GRID_W)
    col_start = jnp.clip(cols - NA_COLS // 2, 0, GRID_W - NA_COLS)
    col_ok = (cols[None, :] >= col_start[:, None]) & (cols[None, :] < col_start[:, None] + NA_COLS)
    dc_idx = jnp.clip(cols[None, :] - cols[:, None] + NA_COLS - 1, 0, 2 * NA_COLS - 2)
    mask = jnp.broadcast_to(col_ok[:, None, :], (GRID_W, kr, GRID_W)).reshape(GRID_W, n_loc)

    def row_block(r):
        rs = jnp.clip(r - kr // 2, 0, rows - kr)
        q_r = lax.dynamic_index_in_dim(qg, r, axis=1, keepdims=False)
        k_blk = lax.dynamic_slice_in_dim(kg, rs, kr, axis=1).reshape(b, n_loc, NA_HEADS, NA_HEAD_DIM)
        v_blk = lax.dynamic_slice_in_dim(vg, rs, kr, axis=1).reshape(b, n_loc, NA_HEADS, NA_HEAD_DIM)
        dr_idx = rs + jnp.arange(kr) - r + NA_MAX_ROWS - 1
        bias = rel_bias[:, dr_idx[:, None, None], dc_idx[None, :, :]]
        bias = bias.transpose(0, 2, 1, 3).reshape(NA_HEADS, GRID_W, n_loc).astype(jnp.float32)
        s_loc = jnp.einsum('bqhd,bkhd->bhqk', q_r, k_blk).astype(jnp.float32) * NA_SCALE + bias
        s_loc = jnp.where(mask, s_loc, -jnp.inf)
        s_ctx = jnp.einsum('bqhd,bkhd->bhqk', q_r, k_ctx).astype(jnp.float32) * NA_SCALE
        p = softmax_f32(jnp.concatenate([s_loc, s_ctx], axis=-1)).astype(v.dtype)
        return (jnp.einsum('bhqk,bkhd->bqhd', p[..., :n_loc], v_blk)
                + jnp.einsum('bhqk,bkhd->bqhd', p[..., n_loc:], v_ctx))

    o = lax.map(row_block, jnp.arange(rows))
    o = o.transpose(1, 0, 2, 3, 4).reshape(b, n, NA_WIDTH)
    return (o * jax.nn.silu(gate)) @ w_out


def setup_inputs(seed: int = 0) -> dict:
    key = jax.random.key(seed)
    ks = jax.random.split(key, 24)
    nrm = jax.random.normal
    mla_in = Q_LORA_RANK + KV_LORA_RANK + QK_ROPE_DIM + MLA_WIDTH
    return {
        "x_prompt": nrm(ks[0], (BATCH, SEQ, D_MODEL), jnp.float32),
        "x_sample": nrm(ks[1], (DEC_BATCH, DEC_SEQ, D_MODEL), jnp.float32),
        "cache_mla_ckv": nrm(ks[2], (DEC_BATCH, N_MLA_LAYERS, PAST_LEN, KV_LORA_RANK), jnp.float32),
        "cache_mla_krope": nrm(ks[3], (DEC_BATCH, N_MLA_LAYERS, PAST_LEN, QK_ROPE_DIM), jnp.float32),
        "cache_na_k": nrm(ks[4], (DEC_BATCH, N_NA_LAYERS, PAST_LEN, NA_HEADS, NA_HEAD_DIM), jnp.float32),
        "cache_na_v": nrm(ks[5], (DEC_BATCH, N_NA_LAYERS, PAST_LEN, NA_HEADS, NA_HEAD_DIM), jnp.float32),
        "c": nrm(ks[6], (DEC_BATCH, D_MODEL), jnp.float32),
        "c_ctx": nrm(ks[7], (D_MODEL,), jnp.float32),
        "w_ada": nrm(ks[8], (DEPTH, D_MODEL, 3 * D_MODEL), jnp.float32) * D_MODEL ** -0.5,
        "b_ada": nrm(ks[9], (DEPTH, 3 * D_MODEL), jnp.float32) * 0.02,
        "pre_norm_g": 1.0 + 0.05 * nrm(ks[10], (DEPTH, D_MODEL), jnp.float32),
        "post_norm_g": 1.0 + 0.05 * nrm(ks[11], (DEPTH, D_MODEL), jnp.float32),
        "mla_w_in": nrm(ks[12], (N_MLA_LAYERS, D_MODEL, mla_in), jnp.float32) * D_MODEL ** -0.5,
        "mla_q_norm_g": 1.0 + 0.05 * nrm(ks[13], (N_MLA_LAYERS, Q_LORA_RANK), jnp.float32),
        "mla_w_qb": nrm(ks[14], (N_MLA_LAYERS, Q_LORA_RANK, MLA_HEADS * (QK_NOPE_DIM + QK_ROPE_DIM)), jnp.float32) * Q_LORA_RANK ** -0.5,
        "mla_kv_norm_g": 1.0 + 0.05 * nrm(ks[15], (N_MLA_LAYERS, KV_LORA_RANK), jnp.float32),
        "mla_w_kvb": nrm(ks[16], (N_MLA_LAYERS, KV_LORA_RANK, MLA_HEADS * (QK_NOPE_DIM + V_HEAD_DIM)), jnp.float32) * KV_LORA_RANK ** -0.5,
        "mla_w_out": nrm(ks[17], (N_MLA_LAYERS, MLA_WIDTH, D_MODEL), jnp.float32) * MLA_WIDTH ** -0.5,
        "na_w_in": nrm(ks[18], (N_NA_LAYERS, D_MODEL, 4 * NA_WIDTH), jnp.float32) * D_MODEL ** -0.5,
        "na_rel_bias": nrm(ks[19], (N_NA_LAYERS, NA_HEADS, 2 * NA_MAX_ROWS - 1, 2 * NA_COLS - 1), jnp.float32) * 0.5,
        "na_w_out": nrm(ks[20], (N_NA_LAYERS, NA_WIDTH, D_MODEL), jnp.float32) * NA_WIDTH ** -0.5,
    }


def reference(x_prompt, x_sample, cache_mla_ckv, cache_mla_krope, cache_na_k, cache_na_v, c, c_ctx,
              w_ada, b_ada, pre_norm_g, post_norm_g, mla_w_in, mla_q_norm_g, mla_w_qb, mla_kv_norm_g,
              mla_w_kvb, mla_w_out, na_w_in, na_rel_bias, na_w_out):
    xp, xs = x_prompt, x_sample
    new_ckv, new_krope, new_k, new_v = [], [], [], []
    for i in range(DEPTH):
        j = i // N_MIXERS
        sh_p, sc_p, g_p = modulation(c_ctx, w_ada[i], b_ada[i])
        sh_s, sc_s, g_s = modulation(c, w_ada[i], b_ada[i])
        hp = rms_norm(xp, pre_norm_g[i]) * (1.0 + sc_p) + sh_p
        hs = rms_norm(xs, pre_norm_g[i]) * (1.0 + sc_s[:, None]) + sh_s[:, None]
        if i % N_MIXERS == 0:
            op, ckv, krope = mla_context(hp, mla_w_in[j], mla_q_norm_g[j], mla_w_qb[j], mla_kv_norm_g[j],
                                         mla_w_kvb[j], mla_w_out[j])
            osm = mla_latent(hs, cache_mla_ckv[:, j], cache_mla_krope[:, j], mla_w_in[j], mla_q_norm_g[j],
                             mla_w_qb[j], mla_kv_norm_g[j], mla_w_kvb[j], mla_w_out[j])
            new_ckv.append(ckv)
            new_krope.append(krope)
        else:
            op, kc, vc = na_context(hp, na_w_in[j], na_w_out[j])
            osm = na_latent(hs, cache_na_k[:, j], cache_na_v[:, j], na_w_in[j], na_rel_bias[j], na_w_out[j])
            new_k.append(kc)
            new_v.append(vc)
        xp = xp + g_p * rms_norm(op, post_norm_g[i])
        xs = xs + g_s[:, None] * rms_norm(osm, post_norm_g[i])
    state_mla_ckv = jnp.stack(new_ckv, axis=1)
    state_mla_krope = jnp.stack(new_krope, axis=1)
    state_na_k = jnp.stack(new_k, axis=1)
    state_na_v = jnp.stack(new_v, axis=1)
    return (xp, xs, state_mla_ckv, state_mla_krope, state_na_k, state_na_v)
```

```cpp
#include <hip/hip_runtime.h>
#include <hip/hip_bf16.h>
#include <hip/hip_cooperative_groups.h>
#include <cstdio>
#include <cstdint>
namespace cg = cooperative_groups;


typedef unsigned short u16;
using bf16x8 = __attribute__((ext_vector_type(8))) short;
using s16x4  = __attribute__((ext_vector_type(4))) short;
using f32x4  = __attribute__((ext_vector_type(4))) float;
using f32x16 = __attribute__((ext_vector_type(16))) float;
using u32x4  = __attribute__((ext_vector_type(4))) unsigned;
using u32x2  = __attribute__((ext_vector_type(2))) unsigned;
#define LAS __attribute__((address_space(3)))
#define GAS __attribute__((address_space(1)))

constexpr int DM = 1024, NTOK_P = 8192, NTOK_S = 32768, NTOK = 40960;
constexpr int SEQP = 256, SEQS = 4096, PAST = 256, KEYS_S = 4352;
constexpr int NTHREADS = 512;
constexpr int LDS_MAIN = 131072;
constexpr float LOG2E = 1.4426950408889634f;
constexpr float MLA_QS = 0.07216878364870322f * LOG2E;
constexpr float NA_QS = 0.125f * LOG2E;
constexpr float EPSN = 1e-6f;

constexpr size_t MiB = 1048576;
constexpr size_t WS_WT1 = 0;
constexpr size_t WS_WTQ = 5 * MiB;
constexpr size_t WS_WTV = 7 * MiB;
constexpr size_t WS_WTO = 9 * MiB;
constexpr size_t WS_WTN = 13 * MiB;
constexpr size_t WS_WTNO = 21 * MiB;
constexpr size_t WS_MOD = 23 * MiB;
constexpr size_t WS_KS = 24 * MiB;
constexpr size_t WS_KP = 37 * MiB;
constexpr size_t WS_CNK = 40 * MiB;
constexpr size_t WS_CNV = 44 * MiB;
constexpr size_t WS_BAR = 48 * MiB;
constexpr size_t WS_B = 64 * MiB;
constexpr size_t WS_C = 224 * MiB;
constexpr size_t WS_QN = 464 * MiB;
constexpr size_t WS_END = 484 * MiB;
constexpr size_t WS_GATE = WS_B;
constexpr size_t WS_Q = WS_C;
constexpr size_t WS_H = WS_C;
constexpr size_t WS_P1 = WS_C + 80 * MiB;
constexpr size_t WS_OSM = WS_C;
constexpr size_t WS_H1 = WS_B;
constexpr size_t WS_NG = WS_B + 80 * MiB;
constexpr size_t WS_NQ = WS_C;
constexpr size_t WS_NK = WS_C + 80 * MiB;
constexpr size_t WS_NV = WS_C + 160 * MiB;
constexpr size_t WS_OSM2 = WS_B;
constexpr size_t OUT_Y = 0, OUT_CKV = 41943040, OUT_KROPE = 42991616, OUT_NAK = 43515904, OUT_NAV = 51904512;

struct Params {
  const float *x_prompt, *x_sample, *c_ckv, *c_krope, *c_nak, *c_nav, *c, *c_ctx, *w_ada, *b_ada, *pre_g, *post_g;
  const float *w_in, *qg, *w_qb, *kvg, *w_kvb, *w_out, *na_w_in, *na_bias, *na_w_out;
  float* out; char* ws;
};

__device__ __forceinline__ u16 f2bf(float f) { unsigned u = __float_as_uint(f); u += 0x7fffu + ((u >> 16) & 1u); return (u16)(u >> 16); }
__device__ __forceinline__ float bf2f(u16 x) { return __uint_as_float(((unsigned)x) << 16); }
__device__ __forceinline__ unsigned cvtpk(float lo, float hi) {
  unsigned r; asm volatile("v_cvt_pk_bf16_f32 %0, %1, %2" : "=v"(r) : "v"(lo), "v"(hi)); return r;
}
__device__ __forceinline__ float siluf(float x) { return x / (1.f + __expf(-x)); }
__device__ __forceinline__ float wave_sum(float v) {
#pragma unroll
  for (int o = 32; o > 0; o >>= 1) v += __shfl_xor(v, o);
  return v;
}
__device__ __forceinline__ const float* xrow(const Params& p, int t) {
  return t < NTOK_P ? p.x_prompt + (size_t)t * DM : p.x_sample + (size_t)(t - NTOK_P) * DM;
}
__device__ __forceinline__ int modrow(int t) { return t < NTOK_P ? 0 : 1 + ((t - NTOK_P) >> 12); }
__device__ __forceinline__ int vblock() { int g = gridDim.x; return ((g & 7) == 0) ? (int)((blockIdx.x & 7) * (g >> 3) + (blockIdx.x >> 3)) : (int)blockIdx.x; }

constexpr int BM = 256, BK = 64, HALF = 128, HTB = HALF * BK * 2, NXCD = 8, WGM = 8;
__device__ __forceinline__ int lds_byte(int r, int c) { const int st = (r >> 4) * 2 + (c >> 5), rr = r & 15, cc = c & 31, ob = rr * 64 + cc * 2; return st * 1024 + (ob ^ (((ob >> 9) & 1) << 5)); }
__device__ __forceinline__ void stage_rc(int b, int& R, int& C) { const int st = b / 1024, sb = b % 1024, swz = sb ^ (((sb >> 9) & 1) << 5); R = (st >> 1) * 16 + swz / 64; C = (st & 1) * 32 + (swz % 64) / 2; }
__device__ __forceinline__ int perm32(int rho) { const int n = rho >> 4, i = rho & 15; return 8 * (i >> 2) + 4 * n + (i & 3); }
struct Unit { int pm, pn; };
struct StaticOrder {
  int nM, nN, nwg, G, c;
  __device__ void init(int M, int N, int G_, int c_) { nM = M / BM; nN = N / BM; nwg = nM * nN; G = G_; c = c_; }
  __device__ bool next(int i, Unit& u) const {
    const long L = (long)i * G + c; if (L >= nwg) return false;
    int wgid = (int)L; { const int q = nwg / NXCD, r = nwg % NXCD, xcd = wgid % NXCD, off = wgid / NXCD; wgid = (xcd < r ? xcd * (q + 1) : r * (q + 1) + (xcd - r) * q) + off; }
    const int nig = WGM * nN, gid = wgid / nig, fm = gid * WGM, gsz = (nM - fm) < WGM ? (nM - fm) : WGM;
    u.pm = fm + ((wgid % nig) % gsz); u.pn = (wgid % nig) / gsz; return true;
  }
};
struct GemmDesc { const u16* A; int lda; int a_pn_off; const u16* Bt; int ldb; int K; int nN; };

template <class E8>
__device__ __forceinline__ void gemm_phase(LAS unsigned char* lds, const GemmDesc g, const E8 E) {
  const int tid = threadIdx.x, wid = __builtin_amdgcn_readfirstlane(tid >> 6), lane = tid & 63, wr = wid >> 2, wc = wid & 3, fr = lane & 15, fq = lane >> 4;
  const int K = g.K, nt = K / BK;
  unsigned voffA[2], voffB[2];
#pragma unroll
  for (int i = 0; i < 2; ++i) { int R, C; stage_rc(tid * 16 + i * 8192, R, C); const int Rb = (R & ~31) + perm32(R & 31);
    voffA[i] = (unsigned)(R * g.lda + C) * 2u; voffB[i] = (unsigned)(Rb * g.ldb + C) * 2u; }
  const size_t kstep = (size_t)(BK * 2);
  const size_t hstepA = (size_t)HALF * g.lda * 2, hstepB = (size_t)HALF * g.ldb * 2;
  const size_t tstepA = 2 * hstepA, tstepB = 2 * hstepB, pnA = (size_t)g.a_pn_off * 2;
  const unsigned ldsw = (unsigned)wid * 1024u;
  const int aoff = lds_byte(wr * 64 + fr, fq * 8), boff = lds_byte(wc * 32 + fr, fq * 8);
#define PG8_SA(b, h) (((b) * 2 + (h)) * HTB)
#define PG8_SB(b, h) ((4 + (b) * 2 + (h)) * HTB)
#define PG8_STAGE(bufoff, gbase, voff) do { _Pragma("unroll") for (int _i = 0; _i < 2; ++_i) \
    __builtin_amdgcn_global_load_lds((const GAS unsigned*)((const char*)(gbase) + (voff)[_i]), (LAS unsigned*)(lds + (bufoff) + ldsw + _i * 8192), 16, 0, 0); } while (0)
#define PG8_LDA(dst, b, h) do { _Pragma("unroll") for (int m = 0; m < 4; ++m) _Pragma("unroll") for (int k = 0; k < 2; ++k) dst[m][k] = *(const LAS bf16x8*)(lds + PG8_SA(b, h) + aoff + m * 2048 + k * 1024); } while (0)
#define PG8_LDB(dst, b, h) do { _Pragma("unroll") for (int n = 0; n < 2; ++n) _Pragma("unroll") for (int k = 0; k < 2; ++k) dst[n][k] = *(const LAS bf16x8*)(lds + PG8_SB(b, h) + boff + n * 2048 + k * 1024); } while (0)
#define PG8_MMA(ai, bj, At, Bt_) do { __builtin_amdgcn_s_setprio(1); _Pragma("unroll") for (int m = 0; m < 4; ++m) _Pragma("unroll") for (int n = 0; n < 2; ++n) _Pragma("unroll") for (int k = 0; k < 2; ++k) \
    acc[ai][bj][m][n] = __builtin_amdgcn_mfma_f32_16x16x32_bf16(Bt_[n][k], At[m][k], acc[ai][bj][m][n], 0, 0, 0); __builtin_amdgcn_s_setprio(0); } while (0)
#define PG8_WAIT_V(n) asm volatile("s_waitcnt vmcnt(" #n ")" ::: "memory")
#define PG8_WAIT_L(n) asm volatile("s_waitcnt lgkmcnt(" #n ")" ::: "memory")
#define PG8_BAR __builtin_amdgcn_s_barrier()
#define PG8_SCHED __builtin_amdgcn_sched_barrier(0)
  StaticOrder S; S.init(NTOK, g.nN * BM, (int)gridDim.x, (int)blockIdx.x);
  Unit cur, nxt; int ui = 0;
  if (!S.next(0, cur)) return;
  f32x4 acc[2][2][4][2];
#pragma unroll
  for (int a = 0; a < 2; ++a)
#pragma unroll
    for (int b = 0; b < 2; ++b)
#pragma unroll
      for (int m = 0; m < 4; ++m)
#pragma unroll
        for (int n = 0; n < 2; ++n) acc[a][b][m][n] = (f32x4){0.f, 0.f, 0.f, 0.f};
  bf16x8 At[4][2], B0[2][2], B1[2][2];
  const char* cA = (const char*)g.A + (size_t)cur.pm * tstepA + (size_t)cur.pn * pnA; const char* cB = (const char*)g.Bt + (size_t)cur.pn * tstepB;
  PG8_STAGE(PG8_SB(0, 0), cB, voffB); PG8_STAGE(PG8_SA(0, 0), cA, voffA); PG8_STAGE(PG8_SB(0, 1), cB + hstepB, voffB); PG8_STAGE(PG8_SA(0, 1), cA + hstepA, voffA);
  if (wr == 1) PG8_BAR;
  PG8_WAIT_V(4); PG8_BAR;
  PG8_STAGE(PG8_SB(1, 0), cB + kstep, voffB); PG8_STAGE(PG8_SA(1, 0), cA + kstep, voffA); PG8_STAGE(PG8_SB(1, 1), cB + hstepB + kstep, voffB);
  PG8_WAIT_V(6); PG8_BAR;
  for (;;) {
    const bool has_next = S.next(ui + 1, nxt);
    const char* nA = has_next ? (const char*)g.A + (size_t)nxt.pm * tstepA + (size_t)nxt.pn * pnA : cA; const char* nB = has_next ? (const char*)g.Bt + (size_t)nxt.pn * tstepB : cB;
#pragma nounroll
    for (int t = 0; t < nt; t += 2) {
      const bool last = (t == nt - 2);
      const char* a1 = cA + (size_t)(t + 1) * kstep;
      const char* a2 = last ? nA : cA + (size_t)(t + 2) * kstep; const char* b2 = last ? nB : cB + (size_t)(t + 2) * kstep;
      const char* a3 = a2 + kstep; const char* b3 = b2 + kstep;
      PG8_LDB(B0, 0, 0); PG8_SCHED; PG8_LDA(At, 0, 0); PG8_STAGE(PG8_SA(1, 1), a1 + hstepA, voffA);
      PG8_WAIT_L(8); PG8_BAR; PG8_WAIT_L(0); PG8_MMA(0, 0, At, B0); PG8_BAR; PG8_SCHED;
      PG8_LDB(B1, 0, 1); PG8_STAGE(PG8_SB(0, 0), b2, voffB);
      PG8_BAR; PG8_WAIT_L(0); PG8_MMA(0, 1, At, B1); PG8_BAR;
      PG8_LDA(At, 0, 1); PG8_STAGE(PG8_SA(0, 0), a2, voffA);
      PG8_BAR; PG8_WAIT_L(0); PG8_MMA(1, 0, At, B0); PG8_BAR; PG8_SCHED;
      PG8_STAGE(PG8_SB(0, 1), b2 + hstepB, voffB);
      PG8_WAIT_V(6); PG8_BAR; PG8_MMA(1, 1, At, B1); PG8_BAR;
      PG8_LDB(B0, 1, 0); PG8_SCHED; PG8_LDA(At, 1, 0); PG8_STAGE(PG8_SA(0, 1), a2 + hstepA, voffA);
      PG8_WAIT_L(8); PG8_BAR; PG8_WAIT_L(0); PG8_MMA(0, 0, At, B0); PG8_BAR; PG8_SCHED;
      PG8_LDB(B1, 1, 1); PG8_STAGE(PG8_SB(1, 0), b3, voffB);
      PG8_BAR; PG8_WAIT_L(0); PG8_MMA(0, 1, At, B1); PG8_BAR;
      PG8_LDA(At, 1, 1); PG8_STAGE(PG8_SA(1, 0), a3, voffA);
      PG8_BAR; PG8_WAIT_L(0); PG8_MMA(1, 0, At, B0); PG8_BAR; PG8_SCHED;
      PG8_STAGE(PG8_SB(1, 1), b3 + hstepB, voffB);
      PG8_WAIT_V(6); PG8_BAR; PG8_MMA(1, 1, At, B1); PG8_BAR;
    }
    { const int row0 = cur.pm * BM + wr * 64 + fr, col0 = cur.pn * BM + wc * 32 + 8 * fq;
#pragma unroll
      for (int ai = 0; ai < 2; ++ai)
#pragma unroll
        for (int m = 0; m < 4; ++m)
#pragma unroll
          for (int bj = 0; bj < 2; ++bj) { E(row0 + ai * HALF + m * 16, col0 + bj * HALF, acc[ai][bj][m][0], acc[ai][bj][m][1]); if (E8::SERIAL) PG8_SCHED; } }
    if (!has_next) break;
#pragma unroll
    for (int a = 0; a < 2; ++a)
#pragma unroll
      for (int b = 0; b < 2; ++b)
#pragma unroll
        for (int m = 0; m < 4; ++m)
#pragma unroll
          for (int n = 0; n < 2; ++n) acc[a][b][m][n] = (f32x4){0.f, 0.f, 0.f, 0.f};
    cur = nxt; cA = nA; cB = nB; ++ui;
  }
  PG8_WAIT_V(0);
  if (wr == 0) PG8_BAR;
  PG8_BAR;
#undef PG8_SA
#undef PG8_SB
#undef PG8_STAGE
#undef PG8_LDA
#undef PG8_LDB
#undef PG8_MMA
#undef PG8_WAIT_V
#undef PG8_WAIT_L
#undef PG8_BAR
#undef PG8_SCHED
}

__device__ __forceinline__ u32x4 pack8(f32x4 a, f32x4 b) { u32x4 w = {cvtpk(a[0], a[1]), cvtpk(a[2], a[3]), cvtpk(b[0], b[1]), cvtpk(b[2], b[3])}; return w; }
__device__ __forceinline__ f32x4 silu4(f32x4 v) { f32x4 r = {siluf(v[0]), siluf(v[1]), siluf(v[2]), siluf(v[3])}; return r; }
__device__ __forceinline__ void unpack8(u32x4 w, f32x4& a, f32x4& b) {
  a[0] = __uint_as_float(w[0] << 16); a[1] = __uint_as_float(w[0] & 0xffff0000u); a[2] = __uint_as_float(w[1] << 16); a[3] = __uint_as_float(w[1] & 0xffff0000u);
  b[0] = __uint_as_float(w[2] << 16); b[1] = __uint_as_float(w[2] & 0xffff0000u); b[2] = __uint_as_float(w[3] << 16); b[3] = __uint_as_float(w[3] & 0xffff0000u);
}
struct EpiG1 {   static constexpr bool SERIAL = false;
  u16* gate; float* p1;
  __device__ __forceinline__ void operator()(int row, int col, f32x4 v0, f32x4 v1) const {
    if (col < 2048) { *reinterpret_cast<u32x4*>(gate + (size_t)row * 2048 + col) = pack8(silu4(v0), silu4(v1)); }
    else { int c = col - 2048; if (c < 448) { float* q = p1 + (size_t)row * 448 + c; *reinterpret_cast<f32x4*>(q) = v0; *reinterpret_cast<f32x4*>(q + 4) = v1; } }
  }
};
struct EpiG2 {   static constexpr bool SERIAL = true;
  u16* q;
  __device__ __forceinline__ void operator()(int row, int col, f32x4 v0, f32x4 v1) const {
    int j = col % 192;
    if (j >= 128 && row >= NTOK_P) {
      j -= 128; int n = (row - NTOK_P) & 4095; float pos = (float)((j & 32) ? (n & 63) : (n >> 6)); int f0 = (j & 31) >> 1;
#define ROT(X, Y, F) do { float inv = exp2f(-(float)(F) * (13.287712379549449f / 16.f)); float ang = pos * inv, cs = __cosf(ang), sn = __sinf(ang); \
        float o0 = X * cs - Y * sn, o1 = Y * cs + X * sn; X = o0; Y = o1; } while (0)
      ROT(v0[0], v0[1], f0); ROT(v0[2], v0[3], f0 + 1); ROT(v1[0], v1[1], f0 + 2); ROT(v1[2], v1[3], f0 + 3);
#undef ROT
    }
    *reinterpret_cast<u32x4*>(q + (size_t)row * 3072 + col) = pack8(v0 * MLA_QS, v1 * MLA_QS);
  }
};
struct EpiG3 {   static constexpr bool SERIAL = true;
  u16* g;
  __device__ __forceinline__ void operator()(int row, int col, f32x4 v0, f32x4 v1) const {
    u32x4* d = reinterpret_cast<u32x4*>(g + (size_t)row * 2048 + col); f32x4 g0, g1; unpack8(*d, g0, g1);
    *d = pack8(v0 * g0, v1 * g1);
  }
};
struct EpiStore {   static constexpr bool SERIAL = false;
  u16* o;
  __device__ __forceinline__ void operator()(int row, int col, f32x4 v0, f32x4 v1) const {
    *reinterpret_cast<u32x4*>(o + (size_t)row * 1024 + col) = pack8(v0, v1);
  }
};
struct EpiG5 {   static constexpr bool SERIAL = false;
  u16 *nq, *nk, *nv, *ng; float *sk, *sv;
  __device__ __forceinline__ void operator()(int row, int col, f32x4 v0, f32x4 v1) const {
    int sec = col >> 10, c = col & 1023; size_t o = (size_t)row * 1024 + c;
    if (sec == 0) { *reinterpret_cast<u32x4*>(nq + o) = pack8(v0 * NA_QS, v1 * NA_QS); }
    else if (sec == 1) { *reinterpret_cast<u32x4*>(nk + o) = pack8(v0, v1); if (row < NTOK_P) { *reinterpret_cast<f32x4*>(sk + o) = v0; *reinterpret_cast<f32x4*>(sk + o + 4) = v1; } }
    else if (sec == 2) { *reinterpret_cast<u32x4*>(nv + o) = pack8(v0, v1); if (row < NTOK_P) { *reinterpret_cast<f32x4*>(sv + o) = v0; *reinterpret_cast<f32x4*>(sv + o + 4) = v1; } }
    else { *reinterpret_cast<u32x4*>(ng + o) = pack8(silu4(v0), silu4(v1)); }
  }
};

#define KSWZ(row, colB) ((row) * 256 + ((colB) ^ (((row) & 15) << 4)))
#define RSWZ(row, colB) ((row) * 128 + ((colB) ^ ((((row) >> 1) & 7) << 4)))
#define SBAR() __builtin_amdgcn_sched_barrier(0)
constexpr float THRL = 11.5f;
__device__ __forceinline__ int crow(int r, int hi) { return (r & 3) + 8 * (r >> 2) + 4 * hi; }

__device__ __forceinline__ void partialSM(f32x16& p0, f32x16& p1, float& m_reg, float& mn, float& alpha) {
  float pmax = p0[0];
#pragma unroll
  for (int r = 1; r < 16; ++r) pmax = fmaxf(pmax, p0[r]);
#pragma unroll
  for (int r = 0; r < 16; ++r) pmax = fmaxf(pmax, p1[r]);
  { auto rr = __builtin_amdgcn_permlane32_swap(__float_as_uint(pmax), __float_as_uint(pmax), false, false);
    pmax = fmaxf(__uint_as_float(rr[0]), __uint_as_float(rr[1])); }
  if (__builtin_expect(__all(pmax - m_reg <= THRL), 1)) { mn = m_reg; alpha = 1.f; }
  else { mn = fmaxf(m_reg, pmax); alpha = __builtin_amdgcn_exp2f(m_reg - mn); m_reg = mn; }
#pragma unroll
  for (int r = 0; r < 16; ++r) p0[r] = p0[r] - mn;
#pragma unroll
  for (int r = 0; r < 16; ++r) p1[r] = p1[r] - mn;
#pragma unroll
  for (int r = 0; r < 16; ++r) p0[r] = __builtin_amdgcn_exp2f(p0[r]);
}
__device__ __forceinline__ void partialSM_pre(f32x16& p0, f32x16& p1, float& m_reg, float& alpha) {
  float pmax = p0[0];
#pragma unroll
  for (int r = 1; r < 16; ++r) pmax = fmaxf(pmax, p0[r]);
#pragma unroll
  for (int r = 0; r < 16; ++r) pmax = fmaxf(pmax, p1[r]);
  { auto rr = __builtin_amdgcn_permlane32_swap(__float_as_uint(pmax), __float_as_uint(pmax), false, false);
    pmax = fmaxf(__uint_as_float(rr[0]), __uint_as_float(rr[1])); }
  if (__builtin_expect(__all(pmax <= THRL), 1)) { alpha = 1.f; }
  else { const float d = fmaxf(pmax, 0.f); alpha = __builtin_amdgcn_exp2f(-d); m_reg += d;
#pragma unroll
    for (int r = 0; r < 16; ++r) { p0[r] -= d; p1[r] -= d; } }
#pragma unroll
  for (int r = 0; r < 16; ++r) p0[r] = __builtin_amdgcn_exp2f(p0[r]);
}
__device__ __forceinline__ void finishSM(f32x16& p0, f32x16& p1, float alpha, float& l_reg, bf16x8& pa0, bf16x8& pa1, bf16x8& pa2, bf16x8& pa3) {
#pragma unroll
  for (int r = 0; r < 16; ++r) p1[r] = __builtin_amdgcn_exp2f(p1[r]);
  float ps = 0;
#pragma unroll
  for (int r = 0; r < 16; ++r) ps += p0[r];
#pragma unroll
  for (int r = 0; r < 16; ++r) ps += p1[r];
  { auto rr = __builtin_amdgcn_permlane32_swap(__float_as_uint(ps), __float_as_uint(ps), false, false);
    ps = __uint_as_float(rr[0]) + __uint_as_float(rr[1]); }
  l_reg = l_reg * alpha + ps;
#define PK4(P, BASE, OUT) do { unsigned a0 = cvtpk(P[BASE + 0], P[BASE + 1]), a1 = cvtpk(P[BASE + 2], P[BASE + 3]);   \
    unsigned b0 = cvtpk(P[BASE + 4], P[BASE + 5]), b1 = cvtpk(P[BASE + 6], P[BASE + 7]);                              \
    auto r0 = __builtin_amdgcn_permlane32_swap(a0, b0, false, false); auto r1 = __builtin_amdgcn_permlane32_swap(a1, b1, false, false); \
    u32x4 w = {r0[0], r1[0], r0[1], r1[1]}; OUT = *reinterpret_cast<bf16x8*>(&w); } while (0)
  PK4(p0, 0, pa0); PK4(p0, 8, pa1); PK4(p1, 0, pa2); PK4(p1, 8, pa3);
#undef PK4
}
__device__ __forceinline__ void finishSM_np(f32x16& p0, f32x16& p1, float alpha, float& l_reg, bf16x8& pa0, bf16x8& pa1, bf16x8& pa2, bf16x8& pa3) {
#pragma unroll
  for (int r = 0; r < 16; ++r) p1[r] = __builtin_amdgcn_exp2f(p1[r]);
  float ps = 0;
#pragma unroll
  for (int r = 0; r < 16; ++r) ps += p0[r];
#pragma unroll
  for (int r = 0; r < 16; ++r) ps += p1[r];
  { auto rr = __builtin_amdgcn_permlane32_swap(__float_as_uint(ps), __float_as_uint(ps), false, false);
    ps = __uint_as_float(rr[0]) + __uint_as_float(rr[1]); }
  l_reg = l_reg * alpha + ps;
#define PKN(P, BASE, OUT) do { u32x4 w = {cvtpk(P[BASE + 0], P[BASE + 1]), cvtpk(P[BASE + 2], P[BASE + 3]), cvtpk(P[BASE + 4], P[BASE + 5]), cvtpk(P[BASE + 6], P[BASE + 7])}; \
    OUT = *reinterpret_cast<bf16x8*>(&w); } while (0)
  PKN(p0, 0, pa0); PKN(p0, 8, pa1); PKN(p1, 0, pa2); PKN(p1, 8, pa3);
#undef PKN
}
__device__ __forceinline__ int v_rd_base(int lane) { return ((lane & 3) << 3) | (((lane >> 2) & 3) << 6) | (((lane >> 4) & 1) << 5) | (((lane >> 5) & 1) << 8); }
template <int OFF> __device__ __forceinline__ s16x4 tr_read(int vb) {
  s16x4 r; asm volatile("ds_read_b64_tr_b16 %0, %1 offset:%2" : "=&v"(r) : "v"(vb), "i"(OFF) : "memory"); return r;
}
template <int NCB, bool SWAP = true> __device__ __forceinline__ int v_st(int k, int c) {
  const int kk = SWAP ? ((k & ~0xC) | ((k & 4) << 1) | ((k & 8) >> 1)) : k;
  return ((kk >> 3) * NCB + (c >> 5)) * 512 + ((kk & 7) * 32 + (c & 31)) * 2;
}
template <int NCB, int D0> __device__ __forceinline__ void pv_one(f32x16& od, int vb, bf16x8 pa0, bf16x8 pa1, bf16x8 pa2, bf16x8 pa3) {
  constexpr int KS = NCB * 1024, HF = NCB * 512;
  const s16x4 l0 = tr_read<D0 * 512 + 0 * KS>(vb), h0 = tr_read<D0 * 512 + 0 * KS + HF>(vb), l1 = tr_read<D0 * 512 + 1 * KS>(vb), h1 = tr_read<D0 * 512 + 1 * KS + HF>(vb);
  const s16x4 l2 = tr_read<D0 * 512 + 2 * KS>(vb), h2 = tr_read<D0 * 512 + 2 * KS + HF>(vb), l3 = tr_read<D0 * 512 + 3 * KS>(vb), h3 = tr_read<D0 * 512 + 3 * KS + HF>(vb);
  asm volatile("s_waitcnt lgkmcnt(0)" ::: "memory"); SBAR();
#define PK(L, H) (bf16x8){L[0], L[1], L[2], L[3], H[0], H[1], H[2], H[3]}
  od = __builtin_amdgcn_mfma_f32_32x32x16_bf16(PK(l0, h0), pa0, od, 0, 0, 0);
  od = __builtin_amdgcn_mfma_f32_32x32x16_bf16(PK(l1, h1), pa1, od, 0, 0, 0);
  od = __builtin_amdgcn_mfma_f32_32x32x16_bf16(PK(l2, h2), pa2, od, 0, 0, 0);
  od = __builtin_amdgcn_mfma_f32_32x32x16_bf16(PK(l3, h3), pa3, od, 0, 0, 0);
#undef PK
}

constexpr int M_SHM_V = 16384, M_SHM_KN = 16384, M_SHM_KR = 8192;
constexpr int M_OFF_V = 0, M_OFF_KN = 32768, M_OFF_KR = 65536, M_OFF_WS = 81920;

template <int OFF> __device__ __forceinline__ bf16x8 lds_r128(int a) {
  bf16x8 r; asm volatile("ds_read_b128 %0, %1 offset:%2" : "=&v"(r) : "v"(a), "i"(OFF) : "memory"); return r;
}
#define LGKM_WAIT(n) do { asm volatile("s_waitcnt lgkmcnt(" #n ")" ::: "memory"); SBAR(); } while (0)
constexpr int M_TILE = 40960;
constexpr int M_OFF_WS3 = 3 * M_TILE;
template <int VAR>
__device__ __forceinline__ void mla_attn_body(const u16* __restrict__ Qb, const u16* __restrict__ Kh, int seq, char* lds,
                                              const u16* __restrict__ WvT, u16* __restrict__ Gq) {
  constexpr int LDQ = 3072, LDK = 192;
  const int tid = threadIdx.x, wid = tid >> 6, lane = tid & 63, r32 = lane & 31, hi = lane >> 5, grp = (wid & 1) ^ (wid >> 2);
  float m_reg = -1e30f, l_reg = 0; f32x16 o[4] = {}; bf16x8 qr[12];
  const u16* Qw = Qb + (long)(wid * 32 + r32) * LDQ + hi * 8;
#pragma unroll
  for (int d0 = 0; d0 < 12; ++d0) qr[d0] = *reinterpret_cast<const bf16x8*>(Qw + d0 * 16);
  const int vb0 = (int)(uintptr_t)(LAS char*)lds + v_rd_base(lane);
  const int widu = __builtin_amdgcn_readfirstlane(wid);
  int ov0, ov1, okn0, okn1, okr;
  { auto vsrc = [&](int chunk) { const int sub = chunk * 2 + (lane >> 5), kk = (sub >> 2) * 8 + ((lane & 31) >> 2);
      const int k = kk, c = (sub & 3) * 32 + (lane & 3) * 8; return (k * LDK + c) * 2; };
    auto knsrc = [&](int chunk) { const int row = chunk * 4 + (lane >> 4), slot = (lane & 15) ^ (row & 15); return (row * LDK + slot * 8) * 2; };
    ov0 = vsrc(widu * 2); ov1 = vsrc(widu * 2 + 1); okn0 = knsrc(widu * 2); okn1 = knsrc(widu * 2 + 1);
    const int row = widu * 8 + (lane >> 3), slot = (lane & 7) ^ ((row >> 1) & 7); okr = (row * LDK + 128 + slot * 8) * 2; }
  LAS char* const l3 = (LAS char*)lds;
#define GL_LDS(g, l) __builtin_amdgcn_global_load_lds((const GAS unsigned*)(g), (LAS unsigned*)(l), 16, 0, 0)
#define DMA(boff, k0) do { const char* tb_ = (const char*)(Kh + (long)(k0) * LDK); LAS char* lb_ = l3 + (boff) + widu * 2048;   \
    GL_LDS(tb_ + ov0, lb_); GL_LDS(tb_ + ov1, lb_ + 1024); GL_LDS(tb_ + okn0, lb_ + 16384); GL_LDS(tb_ + okn1, lb_ + 16384 + 1024); \
    GL_LDS(tb_ + okr, l3 + (boff) + 32768 + widu * 1024); } while (0)
#define VM_WAIT0() asm volatile("s_waitcnt vmcnt(0)" ::: "memory")
#define RESC(a) do { if (__any((a) < 1.f)) { for (int d = 0; d < 4; ++d) for (int r = 0; r < 16; ++r) o[d][r] *= (a); } } while (0)
#define PBAR() do { asm volatile("s_waitcnt lgkmcnt(0)" ::: "memory"); __builtin_amdgcn_s_barrier(); asm volatile("" ::: "memory"); } while (0)
  const int NT = seq / 64;
  int dummy_store = 0; if constexpr (VAR != 0) { asm volatile("s_mov_b32 %0, 0" : "=s"(dummy_store)); }
  f32x16 p0, p1; float mn, al; bf16x8 pa0, pa1, pa2, pa3;
  constexpr int QD = 2;
  bf16x8 fa0, fb0, fa1, fb1;
#define RDK(s, FA, FB) do { if ((s) < 8) { int a_ = bK + ((((s) * 32) + hi_ * 16) ^ fK); FA = lds_r128<0>(a_); FB = lds_r128<8192>(a_); }   \
                            else { int a_ = bR + (((((s) - 8) * 32) + hi_ * 16) ^ fR); FA = lds_r128<0>(a_); FB = lds_r128<4096>(a_); } } while (0)
#define STEP(s, FA, FB, W) do { LGKM_WAIT(W); p0 = __builtin_amdgcn_mfma_f32_32x32x16_bf16(FA, qr[s], p0, 0, 0, 0);         \
                                p1 = __builtin_amdgcn_mfma_f32_32x32x16_bf16(FB, qr[s], p1, 0, 0, 0); } while (0)
#define QK_ADDR(boff) int r32_ = r32, hi_ = hi; asm volatile("" : "+v"(r32_), "+v"(hi_));                                    \
    const int fK = (r32_ & 15) << 4, fR = ((r32_ >> 1) & 7) << 4;                                                             \
    const int bK = ldsb + (boff) + 16384 + r32_ * 256, bR = ldsb + (boff) + 32768 + r32_ * 128;
#define QK_HEAD() do { RDK(0, fa0, fb0); RDK(1, fa1, fb1); } while (0)
#define QK_STEPS(SEED) do { { const float sd_ = (SEED); for (int r_ = 0; r_ < 16; ++r_) { p0[r_] = sd_; p1[r_] = sd_; } }                                                                        \
    STEP(0, fa0, fb0, 2); RDK(2, fa0, fb0); STEP(1, fa1, fb1, 2); RDK(3, fa1, fb1); STEP(2, fa0, fb0, 2); RDK(4, fa0, fb0);   \
    STEP(3, fa1, fb1, 2); RDK(5, fa1, fb1); STEP(4, fa0, fb0, 2); RDK(6, fa0, fb0); STEP(5, fa1, fb1, 2); RDK(7, fa1, fb1);   \
    STEP(6, fa0, fb0, 2); RDK(8, fa0, fb0); STEP(7, fa1, fb1, 2); RDK(9, fa1, fb1); STEP(8, fa0, fb0, 2); RDK(10, fa0, fb0);  \
    STEP(9, fa1, fb1, 2); RDK(11, fa1, fb1); STEP(10, fa0, fb0, 2); STEP(11, fa1, fb1, 0); } while (0)
  s16x4 tl0, th0, tl1, th1, tl2, th2, tl3, th3, ul0, uh0, ul1, uh1, ul2, uh2, ul3, uh3;
#define TRG(D0, P, vb) do { P##l0 = tr_read<D0 * 512>(vb); P##h0 = tr_read<D0 * 512 + 2048>(vb); P##l1 = tr_read<D0 * 512 + 4096>(vb); P##h1 = tr_read<D0 * 512 + 6144>(vb);      \
    P##l2 = tr_read<D0 * 512 + 8192>(vb); P##h2 = tr_read<D0 * 512 + 10240>(vb); P##l3 = tr_read<D0 * 512 + 12288>(vb); P##h3 = tr_read<D0 * 512 + 14336>(vb); } while (0)
#define PK(L, H) (bf16x8){L[0], L[1], L[2], L[3], H[0], H[1], H[2], H[3]}
#define PVM(od, P) do { od = __builtin_amdgcn_mfma_f32_32x32x16_bf16(PK(P##l0, P##h0), pa0, od, 0, 0, 0); od = __builtin_amdgcn_mfma_f32_32x32x16_bf16(PK(P##l1, P##h1), pa1, od, 0, 0, 0); \
    od = __builtin_amdgcn_mfma_f32_32x32x16_bf16(PK(P##l2, P##h2), pa2, od, 0, 0, 0); od = __builtin_amdgcn_mfma_f32_32x32x16_bf16(PK(P##l3, P##h3), pa3, od, 0, 0, 0); } while (0)
  const int ldsb = (int)(uintptr_t)(LAS char*)lds;
  DMA(0, 0); VM_WAIT0();
  __syncthreads();
  if (grp == 1) PBAR();
  if (1 < NT) DMA(M_TILE, 64);
  { QK_ADDR(0); QK_HEAD(); QK_STEPS(0.f); }
  VM_WAIT0(); PBAR();
  int bc = 0, bn = M_TILE, bw = 2 * M_TILE;
  for (int j = 0; j < NT; ++j) {
    if constexpr (VAR == 3) { al = 1.f; mn = 0.f;
      { unsigned a0 = cvtpk(p0[0], p0[1]), a1 = cvtpk(p0[2], p0[3]), a2 = cvtpk(p0[4], p0[5]), a3 = cvtpk(p0[6], p0[7]); u32x4 w = {a0, a1, a2, a3}; pa0 = *reinterpret_cast<bf16x8*>(&w); }
      { unsigned a0 = cvtpk(p0[8], p0[9]), a1 = cvtpk(p0[10], p0[11]), a2 = cvtpk(p0[12], p0[13]), a3 = cvtpk(p0[14], p0[15]); u32x4 w = {a0, a1, a2, a3}; pa1 = *reinterpret_cast<bf16x8*>(&w); }
      { unsigned a0 = cvtpk(p1[0], p1[1]), a1 = cvtpk(p1[2], p1[3]), a2 = cvtpk(p1[4], p1[5]), a3 = cvtpk(p1[6], p1[7]); u32x4 w = {a0, a1, a2, a3}; pa2 = *reinterpret_cast<bf16x8*>(&w); }
      { unsigned a0 = cvtpk(p1[8], p1[9]), a1 = cvtpk(p1[10], p1[11]), a2 = cvtpk(p1[12], p1[13]), a3 = cvtpk(p1[14], p1[15]); u32x4 w = {a0, a1, a2, a3}; pa3 = *reinterpret_cast<bf16x8*>(&w); }
      l_reg += p0[0];
    } else {
    if (j == 0) partialSM(p0, p1, m_reg, mn, al); else partialSM_pre(p0, p1, m_reg, al);
    RESC(al);
    finishSM_np(p0, p1, al, l_reg, pa0, pa1, pa2, pa3);
    }
    const int vb = vb0 + bc;
    SBAR(); TRG(0, t, vb);
    PBAR();
    __builtin_amdgcn_s_setprio(1);
    if (j + 2 < NT) DMA(bw, (j + 2) * 64);
    SBAR();
    TRG(1, u, vb);
    PVM(o[0], t);
    TRG(2, t, vb); LGKM_WAIT(8);
    PVM(o[1], u);
    TRG(3, u, vb); LGKM_WAIT(8);
    PVM(o[2], t);
    if (j + 1 < NT) {
      QK_ADDR(bn); QK_HEAD(); LGKM_WAIT(4);
      PVM(o[3], u);
      QK_STEPS(-m_reg);
    } else { LGKM_WAIT(0); PVM(o[3], u); }
    __builtin_amdgcn_s_setprio(0);
    VM_WAIT0(); PBAR();
    { int t_ = bc; bc = bn; bn = bw; bw = t_; }
  }
  if (grp == 0) PBAR();
  { const float rl = __builtin_amdgcn_rcpf(l_reg);
    bf16x8 ob[8];
#pragma unroll
    for (int ks = 0; ks < 8; ++ks) { const int d0 = ks >> 1, t8 = (ks & 1) * 8;
      u32x4 w = {cvtpk(o[d0][t8 + 0] * rl, o[d0][t8 + 1] * rl), cvtpk(o[d0][t8 + 2] * rl, o[d0][t8 + 3] * rl),
                 cvtpk(o[d0][t8 + 4] * rl, o[d0][t8 + 5] * rl), cvtpk(o[d0][t8 + 6] * rl, o[d0][t8 + 7] * rl)};
      ob[ks] = *reinterpret_cast<bf16x8*>(&w); }
    const u16* WT = WvT + (long)r32 * 128 + hi * 4;
    u16* Gw = Gq + (long)(wid * 32 + r32) * 2048 + hi * 4;
    u32x2 wl[4][8][2];
#pragma unroll
    for (int nb = 0; nb < 4; ++nb)
#pragma unroll
      for (int ks = 0; ks < 8; ++ks) { const u16* wp = WT + nb * 32 * 128 + ks * 16;
        wl[nb][ks][0] = *reinterpret_cast<const u32x2*>(wp); wl[nb][ks][1] = *reinterpret_cast<const u32x2*>(wp + 8); }
#pragma unroll
    for (int nb = 0; nb < 4; ++nb) {
      f32x16 c = {};
#pragma unroll
      for (int ks = 0; ks < 8; ++ks) { u32x4 w = {wl[nb][ks][0][0], wl[nb][ks][0][1], wl[nb][ks][1][0], wl[nb][ks][1][1]};
        c = __builtin_amdgcn_mfma_f32_32x32x16_bf16(*reinterpret_cast<bf16x8*>(&w), ob[ks], c, 0, 0, 0); }
#pragma unroll
      for (int g = 0; g < 4; ++g) { u32x2* dp = reinterpret_cast<u32x2*>(Gw + nb * 32 + g * 8); u32x2 gv = *dp;
        float g0 = __uint_as_float(gv[0] << 16), g1 = __uint_as_float(gv[0] & 0xffff0000u), g2 = __uint_as_float(gv[1] << 16), g3 = __uint_as_float(gv[1] & 0xffff0000u);
        u32x2 wv = {cvtpk(c[g * 4 + 0] * g0, c[g * 4 + 1] * g1), cvtpk(c[g * 4 + 2] * g2, c[g * 4 + 3] * g3)};
        if (VAR == 0 || dummy_store) *dp = wv; }
    }
  }
  __syncthreads();
#undef GL_LDS
#undef DMA
#undef VM_WAIT0
#undef RESC
#undef PBAR
#undef RDK
#undef STEP
#undef QK_ADDR
#undef QK_HEAD
#undef QK_STEPS
#undef TRG
#undef PK
#undef PVM
}

constexpr int N_SHM = 8192;
constexpr int N_OFF_V = 0, N_OFF_K = 16384, N_OFF_TBL = 32768, N_OFF_WS = 36864;

__device__ __forceinline__ void na_qkt(f32x16& p0, f32x16& p1, const char* Kr, const bf16x8* qr, int r32, int hi, float seed) {
#pragma unroll
  for (int r = 0; r < 16; ++r) { p0[r] = seed; p1[r] = seed; }
#pragma unroll
  for (int d0 = 0; d0 < 4; ++d0) { int cb = (d0 * 16 + hi * 8) * 2;
    bf16x8 b0 = *reinterpret_cast<const bf16x8*>(Kr + RSWZ(r32, cb));
    bf16x8 b1 = *reinterpret_cast<const bf16x8*>(Kr + RSWZ(32 + r32, cb));
    p0 = __builtin_amdgcn_mfma_f32_32x32x16_bf16(b0, qr[d0], p0, 0, 0, 0);
    p1 = __builtin_amdgcn_mfma_f32_32x32x16_bf16(b1, qr[d0], p1, 0, 0, 0); }
}
__device__ __forceinline__ void na_pv(f32x16* o, int vb, bf16x8 pa0, bf16x8 pa1, bf16x8 pa2, bf16x8 pa3) {
  pv_one<2, 0>(o[0], vb, pa0, pa1, pa2, pa3); pv_one<2, 1>(o[1], vb, pa0, pa1, pa2, pa3);
}
__device__ __forceinline__ void na_mask(f32x16& p0, f32x16& p1, const float* bp, unsigned m0, unsigned m1) {
#pragma unroll
  for (int r = 0; r < 16; ++r) {
    const int kc = (r & 3) + 8 * (r >> 2);
    float b0 = bp[kc], b1 = bp[kc + 32];
    p0[r] = ((m0 >> r) & 1u) ? p0[r] + b0 : -INFINITY;
    p1[r] = ((m1 >> r) & 1u) ? p1[r] + b1 : -INFINITY;
  }
}

__device__ __forceinline__ void na_attn_body(const u16* __restrict__ Qb, const u16* __restrict__ Kc, const u16* __restrict__ Vc,
                                             const u16* __restrict__ Kl, const u16* __restrict__ Vl, int nctx, int NT, int lo,
                                             bool masked, int r0, u16* __restrict__ G, char* lds) {
  constexpr int LD = 1024;
  const int tid = threadIdx.x, wid = tid >> 6, lane = tid & 63, r32 = lane & 31, hi = lane >> 5;
  char* V_lds = lds + N_OFF_V; char* K_lds = lds + N_OFF_K; const float* tbl = (const float*)(lds + N_OFF_TBL);
  float m_reg = -1e30f, l_reg = 0; f32x16 o[2] = {}; bf16x8 qr[4];
  const u16* Qw = Qb + (long)(wid * 32 + r32) * LD + hi * 8;
#pragma unroll
  for (int d0 = 0; d0 < 4; ++d0) qr[d0] = *reinterpret_cast<const bf16x8*>(Qw + d0 * 16);
  const int rr = tid >> 3, rc = (tid & 7) * 8, vst = v_st<2, false>(rr, rc);
  const int vb0 = (int)(uintptr_t)(LAS char*)V_lds + v_rd_base(lane);
  const int rq = r0 + (wid >> 1), cq = (wid & 1) * 32 + r32;
  unsigned m0 = 0, m1 = 0;
  { const int cs = min(max(cq - 8, 0), 48);
#pragma unroll
    for (int r = 0; r < 16; ++r) { int kc = crow(r, hi); m0 |= ((unsigned)(kc - cs) < 16u ? 1u : 0u) << r; m1 |= ((unsigned)(kc + 32 - cs) < 16u ? 1u : 0u) << r; } }
  const float* tbase = tbl + (15 - cq + 4 * hi);
  struct { bf16x8 k, v; } sr_[2];
#define TILEK(j) (((j) < nctx) ? (Kc + (long)(j) * 64 * LD) : (Kl + (long)(lo + (j) - nctx) * 64 * LD))
#define TILEV(j) (((j) < nctx) ? (Vc + (long)(j) * 64 * LD) : (Vl + (long)(lo + (j) - nctx) * 64 * LD))
#define SLOAD(i, j) do { sr_[i].k = *reinterpret_cast<const bf16x8*>(TILEK(j) + (long)rr * LD + rc);  \
    sr_[i].v = *reinterpret_cast<const bf16x8*>(TILEV(j) + (long)rr * LD + rc); } while (0)
#define SWRITE(b, i) do { *(bf16x8*)(V_lds + (b) * N_SHM + vst) = sr_[i].v; *(bf16x8*)(K_lds + (b) * N_SHM + RSWZ(rr, rc * 2)) = sr_[i].k; } while (0)
#define SWAIT() asm volatile("s_waitcnt vmcnt(2)" ::: "memory")
#define RESC(a) do { if (__any((a) < 1.f)) { for (int d = 0; d < 2; ++d) for (int r = 0; r < 16; ++r) o[d][r] *= (a); } } while (0)
#define MASK(P0, P1, j) do { if (masked && (j) >= nctx) na_mask(P0, P1, tbase + (lo + (j) - nctx - rq + 7) * 31, m0, m1); } while (0)
  f32x16 pA0, pA1, pB0, pB1; float mnA, mnB, alA = 1.f, alB = 1.f; bf16x8 pa0, pa1, pa2, pa3;
  const int rs_w = __builtin_amdgcn_readfirstlane(min(max(r0 + (wid >> 1) - 4, 0), 56));
#define VALID(j) (!masked || (j) < nctx || ((unsigned)(lo + (j) - nctx - rs_w) < 8u))
  bool vA = true, vB = true;
  SLOAD(0, 0); asm volatile("s_waitcnt vmcnt(0)" ::: "memory"); SWRITE(0, 0); __syncthreads();
  vA = VALID(0);
  if (vA) { na_qkt(pA0, pA1, K_lds, qr, r32, hi, 0.f); MASK(pA0, pA1, 0); partialSM(pA0, pA1, m_reg, mnA, alA); }
  SLOAD(1, 1); if (2 < NT) SLOAD(0, 2);
  SWAIT(); SWRITE(1, 1); __syncthreads();
  for (int j = 1; j + 1 < NT; j += 2) {
    vB = VALID(j);
    SBAR(); if (vB) { na_qkt(pB0, pB1, K_lds + N_SHM, qr, r32, hi, -m_reg); MASK(pB0, pB1, j); }
    if (vA) finishSM_np(pA0, pA1, alA, l_reg, pa0, pa1, pa2, pa3);
    SBAR();
    SLOAD(1, j + 2); SBAR();
    if (vA) na_pv(o, vb0, pa0, pa1, pa2, pa3);
    if (vB) partialSM_pre(pB0, pB1, m_reg, alB); else alB = 1.f;
    __syncthreads(); SWAIT(); SWRITE(0, 0);
    RESC(alB); __syncthreads();
    vA = VALID(j + 1);
    SBAR(); if (vA) { na_qkt(pA0, pA1, K_lds, qr, r32, hi, -m_reg); MASK(pA0, pA1, j + 1); }
    if (vB) finishSM_np(pB0, pB1, alB, l_reg, pa0, pa1, pa2, pa3);
    SBAR();
    if (j + 3 < NT) SLOAD(0, j + 3); SBAR();
    if (vB) na_pv(o, vb0 + N_SHM, pa0, pa1, pa2, pa3);
    if (vA) partialSM_pre(pA0, pA1, m_reg, alA); else alA = 1.f;
    __syncthreads(); SWAIT(); SWRITE(1, 1);
    RESC(alA); __syncthreads();
  }
  vB = VALID(NT - 1);
  SBAR(); if (vB) { na_qkt(pB0, pB1, K_lds + N_SHM, qr, r32, hi, -m_reg); MASK(pB0, pB1, NT - 1); }
  if (vA) finishSM_np(pA0, pA1, alA, l_reg, pa0, pa1, pa2, pa3);
  SBAR();
  if (vA) na_pv(o, vb0, pa0, pa1, pa2, pa3);
  if (vB) partialSM_pre(pB0, pB1, m_reg, alB); else alB = 1.f;
  __syncthreads(); RESC(alB);
  if (vB) { finishSM_np(pB0, pB1, alB, l_reg, pa0, pa1, pa2, pa3); SBAR();
    na_pv(o, vb0 + N_SHM, pa0, pa1, pa2, pa3); }
  { const float rl = __builtin_amdgcn_rcpf(l_reg);
    u16* Ow = G + (long)(wid * 32 + r32) * LD + hi * 4;
#pragma unroll
    for (int d0 = 0; d0 < 2; ++d0)
#pragma unroll
      for (int g = 0; g < 4; ++g) { u32x2* dp = reinterpret_cast<u32x2*>(Ow + d0 * 32 + g * 8); u32x2 gv = *dp;
        float g0 = __uint_as_float(gv[0] << 16), g1 = __uint_as_float(gv[0] & 0xffff0000u), g2 = __uint_as_float(gv[1] << 16), g3 = __uint_as_float(gv[1] & 0xffff0000u);
        u32x2 w = {cvtpk(o[d0][g * 4 + 0] * rl * g0, o[d0][g * 4 + 1] * rl * g1), cvtpk(o[d0][g * 4 + 2] * rl * g2, o[d0][g * 4 + 3] * rl * g3)};
        *dp = w; } }
  __syncthreads();
#undef TILEK
#undef TILEV
#undef SLOAD
#undef SWRITE
#undef SWAIT
#undef RESC
#undef MASK
#undef VALID
}

__device__ __forceinline__ int rope_phys(int nn) { return (nn & 32) | ((nn & 15) << 1) | ((nn >> 4) & 1); }
__device__ __forceinline__ void tr_tile(const float* __restrict__ src, int lds_, int k0, int n0, u16* __restrict__ dst, int ldd, int dn0, int dk0, float* tile, bool rperm = false) {
  const int tid = threadIdx.x;
#pragma unroll
  for (int i = 0; i < 8; ++i) { int e = tid + i * 512, kk = e >> 6, nn = e & 63;
    tile[kk * 65 + nn] = src ? src[(size_t)(k0 + kk) * lds_ + n0 + nn] : 0.f; }
  __syncthreads();
#pragma unroll
  for (int i = 0; i < 8; ++i) { int e = tid + i * 512, nn = e >> 6, kk = e & 63;
    dst[(size_t)(dn0 + (rperm ? rope_phys(nn) : nn)) * ldd + dk0 + kk] = f2bf(tile[kk * 65 + nn]); }
  __syncthreads();
}

__device__ void phase_prep(const Params& p, char* lds) {
  const int tid = threadIdx.x, vb = vblock(), nb = gridDim.x;
  char* ws = p.ws;
  {
    float* s = (float*)lds;
    float* red = s + 9 * 1024;
    bool any = false;
    for (int it = vb; it < 192; it += nb) {
      if (!any) { for (int e = tid; e < 9 * 1024; e += 512) { int r = e >> 10, k = e & 1023; float v = r == 0 ? p.c_ctx[k] : p.c[(r - 1) * 1024 + k]; s[e] = siluf(v); } __syncthreads(); any = true; }
      int l = it / 96, n0 = (it % 96) * 32, col = tid & 31, kg = tid >> 5;
      const float* w = p.w_ada + (size_t)l * 1024 * 3072 + n0 + col;
      float acc[9];
#pragma unroll
      for (int r = 0; r < 9; ++r) acc[r] = 0.f;
#pragma unroll 16
      for (int k = kg * 64; k < kg * 64 + 64; ++k) { float wv = w[(size_t)k * 3072];
#pragma unroll
        for (int r = 0; r < 9; ++r) acc[r] += s[r * 1024 + k] * wv; }
#pragma unroll
      for (int r = 0; r < 9; ++r) red[(kg * 9 + r) * 32 + col] = acc[r];
      __syncthreads();
      if (tid < 288) { int r = tid >> 5, c = tid & 31; float v = p.b_ada[l * 3072 + n0 + c];
        for (int g = 0; g < 16; ++g) v += red[(g * 9 + r) * 32 + c];
        ((float*)(ws + WS_MOD))[(l * 9 + r) * 3072 + n0 + c] = v; }
      __syncthreads();
    }
    __syncthreads();
  }
  {
    float* tile = (float*)lds;
    u16* wt1 = (u16*)(ws + WS_WT1); u16* wtq = (u16*)(ws + WS_WTQ); u16* wtv = (u16*)(ws + WS_WTV);
    u16* wto = (u16*)(ws + WS_WTO); u16* wtn = (u16*)(ws + WS_WTN); u16* wtno = (u16*)(ws + WS_WTNO);
    for (int it = vb; it < 2560; it += nb) {
      int i = it;
      if (i < 640) { int c = i >> 4, kt = i & 15; int srcn = c < 32 ? 448 + c * 64 : (c < 36 ? (c - 32) * 64 : (c < 38 ? 256 + (c - 36) * 64 : 384));
        tr_tile(c == 39 ? nullptr : p.w_in, 2496, kt * 64, srcn, wt1, 1024, c * 64, kt * 64, tile); continue; }
      i -= 640;
      if (i < 64) { int h = i >> 2, kt = i & 3; tr_tile(p.w_qb, 3072, kt * 64, h * 192 + 128, wtq, 256, h * 192 + 128, kt * 64, tile, true); continue; }
      i -= 64;
      if (i < 64) { int h = i >> 2, nc = (i >> 1) & 1, kt = i & 1;
        tr_tile(p.w_kvb, 4096, kt * 64, h * 256 + 128 + nc * 64, wtv, 128, h * 128 + nc * 64, kt * 64, tile); continue; }
      i -= 64;
      if (i < 512) { int kt = i >> 4, nc = i & 15; tr_tile(p.w_out, 1024, kt * 64, nc * 64, wto, 2048, nc * 64, kt * 64, tile); continue; }
      i -= 512;
      if (i < 1024) { int kt = i >> 6, nc = i & 63; tr_tile(p.na_w_in, 4096, kt * 64, nc * 64, wtn, 1024, nc * 64, kt * 64, tile); continue; }
      i -= 1024;
      { int kt = i >> 4, nc = i & 15; tr_tile(p.na_w_out, 1024, kt * 64, nc * 64, wtno, 1024, nc * 64, kt * 64, tile); }
    }
  }
  {
    float* Bs = (float*)lds;
    float* As = Bs + 128 * 129;
    u16* wtq = (u16*)(ws + WS_WTQ);
    for (int it = (nb == 256 ? vb - 192 : vb); it >= 0 && it < 128; it += (nb == 256 ? 64 : nb)) {
      int h = it >> 3, kt = it & 7;
      for (int e = tid; e < 128 * 128; e += 512) { int j = e >> 7, d = e & 127; Bs[j * 129 + d] = p.w_kvb[(size_t)j * 4096 + h * 256 + d]; }
      for (int e = tid; e < 32 * 128; e += 512) { int k = e >> 7, d = e & 127; As[k * 128 + d] = p.w_qb[(size_t)(kt * 32 + k) * 3072 + h * 192 + d]; }
      __syncthreads();
      int j = tid & 127, kq = tid >> 7;
      float acc[8];
#pragma unroll
      for (int i = 0; i < 8; ++i) acc[i] = 0.f;
      for (int d = 0; d < 128; ++d) { float b = Bs[j * 129 + d];
#pragma unroll
        for (int i = 0; i < 8; ++i) acc[i] += As[(kq * 8 + i) * 128 + d] * b; }
      u32x4 w = {cvtpk(acc[0], acc[1]), cvtpk(acc[2], acc[3]), cvtpk(acc[4], acc[5]), cvtpk(acc[6], acc[7])};
      *reinterpret_cast<u32x4*>(wtq + (size_t)(h * 192 + j) * 256 + kt * 32 + kq * 8) = w;
      __syncthreads();
    }
  }
  {
    u16* ks = (u16*)(ws + WS_KS);
    const int gt = vb * 512 + tid, gs = nb * 512;
    for (int e = gt; e < 8 * 256 * 192; e += gs) { int c = e % 192, bk = e / 192, b = bk >> 8, key = bk & 255;
      float v = c < 128 ? p.c_ckv[(size_t)bk * 128 + c] : p.c_krope[(size_t)bk * 64 + c - 128];
      ks[((size_t)b * KEYS_S + key) * 192 + (c < 128 ? c : 128 + rope_phys(c - 128))] = f2bf(v); }
    u16* cnk = (u16*)(ws + WS_CNK); u16* cnv = (u16*)(ws + WS_CNV);
    for (int e = gt; e < 8 * 256 * 1024 / 4; e += gs) {
      f32x4 a = reinterpret_cast<const f32x4*>(p.c_nak)[e], b = reinterpret_cast<const f32x4*>(p.c_nav)[e];
      u32x2 wa = {cvtpk(a[0], a[1]), cvtpk(a[2], a[3])}, wb = {cvtpk(b[0], b[1]), cvtpk(b[2], b[3])};
      reinterpret_cast<u32x2*>(cnk)[e] = wa; reinterpret_cast<u32x2*>(cnv)[e] = wb; }
  }
}

__device__ void phase_norm0(const Params& p) {
  const int lane = threadIdx.x & 63, wv = vblock() * 8 + (threadIdx.x >> 6), nw = gridDim.x * 8;
  const float* mod = (const float*)(p.ws + WS_MOD);
  u16* H = (u16*)(p.ws + WS_H);
  for (int t0 = wv * 4; t0 < NTOK; t0 += nw * 4) {
    const float* m = mod + modrow(t0) * 3072;
    f32x4 v[4][4]; float ss[4];
#pragma unroll
    for (int k = 0; k < 4; ++k) { const float* x = xrow(p, t0 + k);
#pragma unroll
      for (int i = 0; i < 4; ++i) v[k][i] = __builtin_nontemporal_load(reinterpret_cast<const f32x4*>(x + i * 256 + lane * 4)); }
#pragma unroll
    for (int k = 0; k < 4; ++k) { float s = 0;
#pragma unroll
      for (int i = 0; i < 4; ++i) s += v[k][i][0] * v[k][i][0] + v[k][i][1] * v[k][i][1] + v[k][i][2] * v[k][i][2] + v[k][i][3] * v[k][i][3];
      ss[k] = s; }
#pragma unroll
    for (int o = 32; o > 0; o >>= 1) {
#pragma unroll
      for (int k = 0; k < 4; ++k) ss[k] += __shfl_xor(ss[k], o); }
    float rstd[4];
#pragma unroll
    for (int k = 0; k < 4; ++k) rstd[k] = rsqrtf(ss[k] * (1.f / 1024.f) + EPSN);
#pragma unroll
    for (int i = 0; i < 4; ++i) { int c = i * 256 + lane * 4;
      f32x4 g = *reinterpret_cast<const f32x4*>(p.pre_g + c), sh = *reinterpret_cast<const f32x4*>(m + c), sc = *reinterpret_cast<const f32x4*>(m + 1024 + c);
      f32x4 gs = {g[0] * (1.f + sc[0]), g[1] * (1.f + sc[1]), g[2] * (1.f + sc[2]), g[3] * (1.f + sc[3])};
#pragma unroll
      for (int k = 0; k < 4; ++k) {
        float o0 = v[k][i][0] * rstd[k] * gs[0] + sh[0], o1 = v[k][i][1] * rstd[k] * gs[1] + sh[1];
        float o2 = v[k][i][2] * rstd[k] * gs[2] + sh[2], o3 = v[k][i][3] * rstd[k] * gs[3] + sh[3];
        u32x2 w = {cvtpk(o0, o1), cvtpk(o2, o3)}; __builtin_nontemporal_store(w, reinterpret_cast<u32x2*>(H + (size_t)(t0 + k) * 1024 + c)); } }
  }
}

__device__ void phase_post1(const Params& p) {
  const int lane = threadIdx.x & 63, wv = vblock() * 8 + (threadIdx.x >> 6), nw = gridDim.x * 8;
  const float* P1 = (const float*)(p.ws + WS_P1);
  u16* QN = (u16*)(p.ws + WS_QN); u16* KS = (u16*)(p.ws + WS_KS); u16* KP = (u16*)(p.ws + WS_KP);
  const f32x4 g = *reinterpret_cast<const f32x4*>(p.qg + lane * 4);
  const float kg0 = p.kvg[lane * 2], kg1 = p.kvg[lane * 2 + 1];
  const float inv = exp2f(-(float)(lane & 15) * (13.287712379549449f / 16.f));
  constexpr int R = 4;
  for (int t0 = wv * R; t0 < NTOK; t0 += nw * R) {
    f32x4 qa[R]; float k0[R], k1[R], kr[R], ss[R], s2[R];
#pragma unroll
    for (int k = 0; k < R; ++k) { const float* r = P1 + (size_t)(t0 + k) * 448;
      qa[k] = *reinterpret_cast<const f32x4*>(r + lane * 4); k0[k] = r[256 + lane * 2]; k1[k] = r[256 + lane * 2 + 1]; kr[k] = r[384 + lane]; }
#pragma unroll
    for (int k = 0; k < R; ++k) { ss[k] = qa[k][0] * qa[k][0] + qa[k][1] * qa[k][1] + qa[k][2] * qa[k][2] + qa[k][3] * qa[k][3]; s2[k] = k0[k] * k0[k] + k1[k] * k1[k]; }
#pragma unroll
    for (int o = 32; o > 0; o >>= 1) {
#pragma unroll
      for (int k = 0; k < R; ++k) { ss[k] += __shfl_xor(ss[k], o); s2[k] += __shfl_xor(s2[k], o); } }
#pragma unroll
    for (int k = 0; k < R; ++k) { const int t = t0 + k;
      float rstd = rsqrtf(ss[k] * (1.f / 256.f) + EPSN), rs2 = rsqrtf(s2[k] * (1.f / 128.f) + EPSN);
      u32x2 w = {cvtpk(qa[k][0] * rstd * g[0], qa[k][1] * rstd * g[1]), cvtpk(qa[k][2] * rstd * g[2], qa[k][3] * rstd * g[3])};
      *reinterpret_cast<u32x2*>(QN + (size_t)t * 256 + lane * 4) = w;
      float c0 = k0[k] * rs2 * kg0, c1 = k1[k] * rs2 * kg1, krv = kr[k];
      u16* kd;
      if (t < NTOK_P) {
        kd = KP + (size_t)t * 192;
        p.out[OUT_CKV + (size_t)t * 128 + lane * 2] = c0; p.out[OUT_CKV + (size_t)t * 128 + lane * 2 + 1] = c1;
        p.out[OUT_KROPE + (size_t)t * 64 + lane] = krv;
      } else {
        int ts = t - NTOK_P, b = ts >> 12, n = ts & 4095;
        kd = KS + ((size_t)b * KEYS_S + 256 + n) * 192;
        float pos = (float)((lane & 32) ? (n & 63) : (n >> 6));
        float ang = pos * inv, cs = __cosf(ang), sn = __sinf(ang);
        float other = __shfl_xor(krv, 16);
        krv = (lane & 16) ? (krv * cs + other * sn) : (krv * cs - other * sn);
      }
      *reinterpret_cast<unsigned*>(kd + lane * 2) = cvtpk(c0, c1);
      kd[128 + rope_phys(lane)] = f2bf(krv); }
  }
}

__device__ void phase_mid(const Params& p) {
  const int lane = threadIdx.x & 63, wv = vblock() * 8 + (threadIdx.x >> 6), nw = gridDim.x * 8;
  const float* mod = (const float*)(p.ws + WS_MOD);
  const u16* OSM = (const u16*)(p.ws + WS_OSM); u16* H1 = (u16*)(p.ws + WS_H1);
  constexpr int R = 2;
  for (int t0 = wv * R; t0 < NTOK; t0 += nw * R) {
    const float* m0 = mod + modrow(t0) * 3072; const float* m1 = mod + (9 + modrow(t0)) * 3072;
    u32x2 wo[R][4]; f32x4 xc[R][4];
#pragma unroll
    for (int k = 0; k < R; ++k) { const float* x = xrow(p, t0 + k);
#pragma unroll
      for (int i = 0; i < 4; ++i) { wo[k][i] = __builtin_nontemporal_load(reinterpret_cast<const u32x2*>(OSM + (size_t)(t0 + k) * 1024 + i * 256 + lane * 4)); xc[k][i] = __builtin_nontemporal_load(reinterpret_cast<const f32x4*>(x + i * 256 + lane * 4)); } }
    float ov[R][16], ss[R];
#pragma unroll
    for (int k = 0; k < R; ++k) { float s = 0;
#pragma unroll
      for (int i = 0; i < 4; ++i) { u32x2 w = wo[k][i];
        ov[k][i * 4 + 0] = __uint_as_float(w[0] << 16); ov[k][i * 4 + 1] = __uint_as_float(w[0] & 0xffff0000u);
        ov[k][i * 4 + 2] = __uint_as_float(w[1] << 16); ov[k][i * 4 + 3] = __uint_as_float(w[1] & 0xffff0000u); }
#pragma unroll
      for (int i = 0; i < 16; ++i) s += ov[k][i] * ov[k][i];
      ss[k] = s; }
#pragma unroll
    for (int o = 32; o > 0; o >>= 1) {
#pragma unroll
      for (int k = 0; k < R; ++k) ss[k] += __shfl_xor(ss[k], o); }
    float rstd[R], s2[R];
#pragma unroll
    for (int k = 0; k < R; ++k) { rstd[k] = rsqrtf(ss[k] * (1.f / 1024.f) + EPSN); s2[k] = 0; }
    float x1[R][16];
#pragma unroll
    for (int i = 0; i < 4; ++i) { int c = i * 256 + lane * 4;
      f32x4 pg = *reinterpret_cast<const f32x4*>(p.post_g + c), gg = *reinterpret_cast<const f32x4*>(m0 + 2048 + c);
#pragma unroll
      for (int k = 0; k < R; ++k) { f32x4 r;
#pragma unroll
        for (int e = 0; e < 4; ++e) { r[e] = xc[k][i][e] + gg[e] * (ov[k][i * 4 + e] * rstd[k] * pg[e]); x1[k][i * 4 + e] = r[e]; s2[k] += r[e] * r[e]; }
        u32x2 wx = {cvtpk(r[0], r[1]), cvtpk(r[2], r[3])};
        *reinterpret_cast<u32x2*>(reinterpret_cast<u16*>(p.out + OUT_Y + (size_t)(t0 + k) * 1024) + c) = wx; } }
#pragma unroll
    for (int o = 32; o > 0; o >>= 1) {
#pragma unroll
      for (int k = 0; k < R; ++k) s2[k] += __shfl_xor(s2[k], o); }
    float rstd1[R];
#pragma unroll
    for (int k = 0; k < R; ++k) rstd1[k] = rsqrtf(s2[k] * (1.f / 1024.f) + EPSN);
#pragma unroll
    for (int i = 0; i < 4; ++i) { int c = i * 256 + lane * 4;
      f32x4 g = *reinterpret_cast<const f32x4*>(p.pre_g + 1024 + c), sh = *reinterpret_cast<const f32x4*>(m1 + c), sc = *reinterpret_cast<const f32x4*>(m1 + 1024 + c);
#pragma unroll
      for (int k = 0; k < R; ++k) { float o[4];
#pragma unroll
        for (int e = 0; e < 4; ++e) o[e] = x1[k][i * 4 + e] * rstd1[k] * g[e] * (1.f + sc[e]) + sh[e];
        u32x2 w = {cvtpk(o[0], o[1]), cvtpk(o[2], o[3])}; __builtin_nontemporal_store(w, reinterpret_cast<u32x2*>(H1 + (size_t)(t0 + k) * 1024 + c)); } }
  }
}

__device__ void phase_final(const Params& p) {
  const int lane = threadIdx.x & 63, wv = vblock() * 8 + (threadIdx.x >> 6), nw = gridDim.x * 8;
  const float* mod = (const float*)(p.ws + WS_MOD);
  const u16* OSM = (const u16*)(p.ws + WS_OSM2);
  constexpr int R = 4;
  for (int t0 = wv * R; t0 < NTOK; t0 += nw * R) {
    const float* m1 = mod + (9 + modrow(t0)) * 3072;
    u32x2 wo[R][4], wx[R][4];
#pragma unroll
    for (int k = 0; k < R; ++k)
#pragma unroll
      for (int i = 0; i < 4; ++i) { wo[k][i] = __builtin_nontemporal_load(reinterpret_cast<const u32x2*>(OSM + (size_t)(t0 + k) * 1024 + i * 256 + lane * 4));
        wx[k][i] = __builtin_nontemporal_load(reinterpret_cast<const u32x2*>(reinterpret_cast<const u16*>(p.out + OUT_Y + (size_t)(t0 + k) * 1024) + i * 256 + lane * 4)); }
    float ss[R];
#pragma unroll
    for (int k = 0; k < R; ++k) { float s = 0;
#pragma unroll
      for (int i = 0; i < 4; ++i) { u32x2 w = wo[k][i]; float a0 = __uint_as_float(w[0] << 16), a1 = __uint_as_float(w[0] & 0xffff0000u), a2 = __uint_as_float(w[1] << 16), a3 = __uint_as_float(w[1] & 0xffff0000u);
        s += a0 * a0 + a1 * a1 + a2 * a2 + a3 * a3; }
      ss[k] = s; }
#pragma unroll
    for (int o = 32; o > 0; o >>= 1) {
#pragma unroll
      for (int k = 0; k < R; ++k) ss[k] += __shfl_xor(ss[k], o); }
    float rstd[R];
#pragma unroll
    for (int k = 0; k < R; ++k) rstd[k] = rsqrtf(ss[k] * (1.f / 1024.f) + EPSN);
    asm volatile("s_waitcnt vmcnt(0)" ::: "memory");
#pragma unroll
    for (int i = 0; i < 4; ++i) { int c = i * 256 + lane * 4;
      f32x4 pg = *reinterpret_cast<const f32x4*>(p.post_g + 1024 + c), gg = *reinterpret_cast<const f32x4*>(m1 + 2048 + c);
#pragma unroll
      for (int k = 0; k < R; ++k) { u32x2 w = wo[k][i], xw = wx[k][i];
        float a0 = __uint_as_float(w[0] << 16), a1 = __uint_as_float(w[0] & 0xffff0000u), a2 = __uint_as_float(w[1] << 16), a3 = __uint_as_float(w[1] & 0xffff0000u);
        float x0 = __uint_as_float(xw[0] << 16), x1_ = __uint_as_float(xw[0] & 0xffff0000u), x2 = __uint_as_float(xw[1] << 16), x3 = __uint_as_float(xw[1] & 0xffff0000u);
        f32x4 r = {x0 + gg[0] * (a0 * rstd[k] * pg[0]), x1_ + gg[1] * (a1 * rstd[k] * pg[1]), x2 + gg[2] * (a2 * rstd[k] * pg[2]), x3 + gg[3] * (a3 * rstd[k] * pg[3])};
        __builtin_nontemporal_store(r, reinterpret_cast<f32x4*>(p.out + OUT_Y + (size_t)(t0 + k) * 1024 + c)); } }
  }
}

template <int VAR>
__device__ void phase_mla_attn(const Params& p, char* lds) {
  const u16* Q = (const u16*)(p.ws + WS_Q); const u16* KS = (const u16*)(p.ws + WS_KS); const u16* KP = (const u16*)(p.ws + WS_KP);
  const u16* WVT = (const u16*)(p.ws + WS_WTV); u16* GT = (u16*)(p.ws + WS_GATE);
  const int nb = gridDim.x, vb = vblock();
  for (int it = vb; it < 2048; it += nb) {
    int per = nb >> 3, xcd = (per > 0 && (nb & 7) == 0) ? vb / per : 0;
    int idx = it;
    if ((nb & 7) == 0 && (256 % per) == 0) { int round = it / nb; int local = vb - xcd * per; idx = xcd * 256 + round * per + local; }
    int b = idx >> 8, h = (idx >> 4) & 15, qt = idx & 15;
    mla_attn_body<VAR>(Q + (size_t)(NTOK_P + b * SEQS + qt * 256) * 3072 + h * 192, KS + (size_t)b * KEYS_S * 192, KEYS_S, lds,
                       WVT + (size_t)h * 128 * 128, GT + (size_t)(NTOK_P + b * SEQS + qt * 256) * 2048 + h * 128);
  }
  for (int it = vb; it < 512; it += nb) {
    int bp = it >> 4, h = it & 15;
    mla_attn_body<VAR>(Q + (size_t)(bp * 256) * 3072 + h * 192, KP + (size_t)bp * 256 * 192, 256, lds,
                       WVT + (size_t)h * 128 * 128, GT + (size_t)(bp * 256) * 2048 + h * 128);
  }
}

__device__ void phase_na_attn(const Params& p, char* lds) {
  const u16* NQ = (const u16*)(p.ws + WS_NQ); const u16* NK = (const u16*)(p.ws + WS_NK); const u16* NV = (const u16*)(p.ws + WS_NV);
  u16* NG = (u16*)(p.ws + WS_NG); const u16* CNK = (const u16*)(p.ws + WS_CNK); const u16* CNV = (const u16*)(p.ws + WS_CNV);
  float* tbl = (float*)(lds + N_OFF_TBL);
  const int nb = gridDim.x, vb = vblock(), tid = threadIdx.x;
  for (int it = vb; it < 2048; it += nb) {
    int per = nb >> 3, xcd = (per > 0 && (nb & 7) == 0) ? vb / per : 0;
    int idx = it;
    if ((nb & 7) == 0 && (256 % per) == 0) { int round = it / nb; int local = vb - xcd * per; idx = xcd * 256 + round * per + local; }
    int b = idx >> 8, h = (idx >> 4) & 15, rq4 = idx & 15, r0 = rq4 * 4;
    for (int e = tid; e < 465; e += 512) tbl[e] = p.na_bias[h * 465 + e] * LOG2E;
    __syncthreads();
    int lo = min(max(r0 - 4, 0), 56), hir = min(max(r0 - 1, 0), 56) + 7, nloc = hir - lo + 1;
    int NT = 4 + ((nloc + 1) & ~1);
    size_t tok0 = (size_t)NTOK_P + (size_t)b * SEQS;
    na_attn_body(NQ + (tok0 + r0 * 64) * 1024 + h * 64, CNK + (size_t)b * 256 * 1024 + h * 64, CNV + (size_t)b * 256 * 1024 + h * 64,
                 NK + tok0 * 1024 + h * 64, NV + tok0 * 1024 + h * 64, 4, NT, lo, true, r0, NG + (tok0 + r0 * 64) * 1024 + h * 64, lds);
  }
  for (int it = vb; it < 512; it += nb) {
    int bp = it >> 4, h = it & 15; size_t o = (size_t)bp * 256 * 1024 + h * 64;
    na_attn_body(NQ + o, NK + o, NV + o, NK + o, NV + o, 4, 4, 0, false, 0, NG + o, lds);
  }
}


#define XB_TMO      128
#define XB_XCNT(j)  (256  + 64 * (j))
#define XB_XSUB(j)  (1280 + 64 * (j))
#define XB_XGEN(j)  (2304 + 64 * (j))
#define XB_TOP      3328
#define XB_TOPGEN   3392
#define XCD_BAR_WORDS 3456
#define XB_SPIN_CAP (1u << 18)
__device__ __forceinline__ unsigned xb_ld(unsigned* p)              { return __hip_atomic_load(p, __ATOMIC_RELAXED, __HIP_MEMORY_SCOPE_AGENT); }
__device__ __forceinline__ unsigned xb_add(unsigned* p, unsigned v) { return __hip_atomic_fetch_add(p, v, __ATOMIC_RELAXED, __HIP_MEMORY_SCOPE_AGENT); }
__device__ __forceinline__ unsigned xb_xcc_id() { return (unsigned)__builtin_amdgcn_s_getreg((3 << 11) | 20) & 0xFu; }
#define XB_SPIN(cond, bar) do { unsigned _sp = 0; while (cond) { __builtin_amdgcn_s_sleep(1); \
    if ((++_sp & 255u) == 0u) { if (xb_ld(&(bar)[XB_TMO])) break; if (_sp > XB_SPIN_CAP) { atomicAdd(&(bar)[XB_TMO], 1u); break; } } } } while (0)
__device__ __forceinline__ void xcd_barrier_complete(unsigned* bar, unsigned x, unsigned& nloc, unsigned& nx) {
  const unsigned G = gridDim.x * gridDim.y * gridDim.z;
  unsigned sum, cnt, mine, sp = 0u;
  for (;;) {
    sum = 0u; cnt = 0u; mine = 0u;
#pragma unroll
    for (unsigned j = 0; j < 16; ++j) { const unsigned c = xb_ld(&bar[XB_XCNT(j)]); sum += c; cnt += (c > 0u) ? 1u : 0u; mine = (j == x) ? c : mine; }
    if (sum == G) break;
    __builtin_amdgcn_s_sleep(1);
    if ((++sp & 255u) == 0u) { if (xb_ld(&bar[XB_TMO])) break; if (sp > XB_SPIN_CAP) { atomicAdd(&bar[XB_TMO], 1u); break; } }
  }
  nloc = mine > 0u ? mine : 1u; nx = cnt > 0u ? cnt : 1u;
}
__device__ __forceinline__ void xcd_barrier(unsigned* bar, volatile LAS unsigned* st) {
  asm volatile("s_waitcnt vmcnt(0)" ::: "memory");
  __syncthreads();
  if (threadIdx.x == 0) {
    const unsigned x = xb_xcc_id();
    __builtin_amdgcn_s_waitcnt(0);
    unsigned nloc = st[0], nx = st[1];
    if (nloc == 0u) { xcd_barrier_complete(bar, x, nloc, nx); st[0] = nloc; st[1] = nx; }
    const unsigned old = xb_add(&bar[XB_XSUB(x)], 1u);
    const unsigned gen = old / nloc;
    if (old + 1u == (gen + 1u) * nloc) {
      __builtin_amdgcn_fence(__ATOMIC_RELEASE, "agent");
      asm volatile("s_waitcnt vmcnt(0)" ::: "memory");
      const unsigned og = xb_add(&bar[XB_TOP], 1u);
      const unsigned tg = og / nx;
      if (og + 1u == (tg + 1u) * nx) xb_add(&bar[XB_TOPGEN], 1u);
      else XB_SPIN(xb_ld(&bar[XB_TOPGEN]) == tg, bar);
      __builtin_amdgcn_fence(__ATOMIC_ACQUIRE, "agent");
      xb_add(&bar[XB_XGEN(x)], 1u);
      asm volatile("s_waitcnt vmcnt(0)" ::: "memory");
    } else {
      XB_SPIN(xb_ld(&bar[XB_XGEN(x)]) == gen, bar);
      __builtin_amdgcn_fence(__ATOMIC_ACQUIRE, "agent");
      asm volatile("s_waitcnt vmcnt(0)" ::: "memory");
    }
  }
  __syncthreads();
}

template <int PHN>
__device__ __forceinline__ void do_phase(const Params& p, char* lds) {
  char* ws = p.ws; LAS unsigned char* l3 = (LAS unsigned char*)lds;
  if constexpr (PHN == 0) phase_prep(p, lds);
  if constexpr (PHN == 1) phase_norm0(p);
  if constexpr (PHN == 2) gemm_phase(l3, GemmDesc{(const u16*)(ws + WS_H), 1024, 0, (const u16*)(ws + WS_WT1), 1024, 1024, 10}, EpiG1{(u16*)(ws + WS_GATE), (float*)(ws + WS_P1)});
  if constexpr (PHN == 3) phase_post1(p);
  if constexpr (PHN == 4) gemm_phase(l3, GemmDesc{(const u16*)(ws + WS_QN), 256, 0, (const u16*)(ws + WS_WTQ), 256, 256, 12}, EpiG2{(u16*)(ws + WS_Q)});
  if constexpr (PHN == 5) phase_mla_attn<0>(p, lds);
  if constexpr (PHN >= 51 && PHN <= 59) phase_mla_attn<PHN - 50>(p, lds);
  if constexpr (PHN == 7) gemm_phase(l3, GemmDesc{(const u16*)(ws + WS_GATE), 2048, 0, (const u16*)(ws + WS_WTO), 2048, 2048, 4}, EpiStore{(u16*)(ws + WS_OSM)});
  if constexpr (PHN == 8) phase_mid(p);
  if constexpr (PHN == 9) gemm_phase(l3, GemmDesc{(const u16*)(ws + WS_H1), 1024, 0, (const u16*)(ws + WS_WTN), 1024, 1024, 16},
                                     EpiG5{(u16*)(ws + WS_NQ), (u16*)(ws + WS_NK), (u16*)(ws + WS_NV), (u16*)(ws + WS_NG), p.out + OUT_NAK, p.out + OUT_NAV});
  if constexpr (PHN == 10) phase_na_attn(p, lds);
  if constexpr (PHN == 11) gemm_phase(l3, GemmDesc{(const u16*)(ws + WS_NG), 1024, 0, (const u16*)(ws + WS_WTNO), 1024, 1024, 4}, EpiStore{(u16*)(ws + WS_OSM2)});
  if constexpr (PHN == 12) phase_final(p);
}
#ifndef PHASE_SEQ
#define PHASE_SEQ X0(0) X(1) X(2) X(3) X(4) X(5) X(7) X(8) X(9) X(10) X(11) L(12)
#endif
__global__ void __launch_bounds__(NTHREADS) fwd_kernel(Params p_arg) {
  extern __shared__ __attribute__((aligned(16))) char lds[];
  const __attribute__((address_space(4))) char* kap = (const __attribute__((address_space(4))) char*)__builtin_amdgcn_kernarg_segment_ptr();
  asm volatile("" : "+s"(kap));
  const Params& p = *(const Params*)(const char*)kap;
#define G1(n) { int g_; asm volatile("s_mov_b32 %0, 1" : "=s"(g_)); if (g_) do_phase<n>(p, lds); }
  unsigned* bar = (unsigned*)(p.ws + WS_BAR);
  volatile LAS unsigned* st = (volatile LAS unsigned*)((LAS char*)lds + LDS_MAIN);
  if (threadIdx.x < 4) st[threadIdx.x] = 0u;
  if (blockIdx.x == 0) { for (int i = threadIdx.x; i < XCD_BAR_WORDS; i += NTHREADS) bar[i] = 0u; }
  __syncthreads();
#define X0(n) G1(n) cg::this_grid().sync(); if (threadIdx.x == 0) (void)xb_add(&bar[XB_XCNT(xb_xcc_id())], 1u);
#define X(n) G1(n) xcd_barrier(bar, st);
#define L(n) G1(n)
  PHASE_SEQ
#undef X0
#undef X
#undef L
#undef G1
}

constexpr int LDS_BYTES = LDS_MAIN + 16;

extern "C" void kernel_launch(void* const* d_in, const int* in_sizes, int n_in, void* d_out, int out_size, void* d_ws, size_t ws_size, hipStream_t stream) {
  static int grid = 0;
  if (grid == 0) {
    if (ws_size < WS_END) { fprintf(stderr, "kernel_launch: workspace too small: %zu < %zu\n", ws_size, (size_t)WS_END); grid = -1; return; }
    if (hipFuncSetAttribute((const void*)fwd_kernel, hipFuncAttributeMaxDynamicSharedMemorySize, LDS_BYTES) != hipSuccess) { fprintf(stderr, "hipFuncSetAttribute failed\n"); grid = -1; return; }
    int dev = 0, cus = 0, per_cu = 0;
    (void)hipGetDevice(&dev); (void)hipDeviceGetAttribute(&cus, hipDeviceAttributeMultiprocessorCount, dev);
    (void)hipOccupancyMaxActiveBlocksPerMultiprocessor(&per_cu, (const void*)fwd_kernel, NTHREADS, LDS_BYTES);
    if (per_cu < 1) { fprintf(stderr, "occupancy query says %d blocks/CU\n", per_cu); per_cu = 1; }
    (void)hipGetLastError();
    grid = cus;
  }
  if (grid < 0) return;
  Params p{};
  p.x_prompt = (const float*)d_in[0]; p.x_sample = (const float*)d_in[1]; p.c_ckv = (const float*)d_in[2]; p.c_krope = (const float*)d_in[3];
  p.c_nak = (const float*)d_in[4]; p.c_nav = (const float*)d_in[5]; p.c = (const float*)d_in[6]; p.c_ctx = (const float*)d_in[7];
  p.w_ada = (const float*)d_in[8]; p.b_ada = (const float*)d_in[9]; p.pre_g = (const float*)d_in[10]; p.post_g = (const float*)d_in[11];
  p.w_in = (const float*)d_in[12]; p.qg = (const float*)d_in[13]; p.w_qb = (const float*)d_in[14]; p.kvg = (const float*)d_in[15];
  p.w_kvb = (const float*)d_in[16]; p.w_out = (const float*)d_in[17]; p.na_w_in = (const float*)d_in[18]; p.na_bias = (const float*)d_in[19];
  p.na_w_out = (const float*)d_in[20]; p.out = (float*)d_out; p.ws = (char*)d_ws;
  void* args[] = {&p};
  hipError_t e = hipLaunchCooperativeKernel((const void*)fwd_kernel, dim3(grid), dim3(NTHREADS), args, LDS_BYTES, stream);
  if (e != hipSuccess) fprintf(stderr, "cooperative launch failed: %s (grid %d)\n", hipGetErrorString(e), grid);
}
```

```cpp
#include <hip/hip_runtime.h>
#include <hip/hip_bf16.h>
#include <hip/hip_cooperative_groups.h>
#include <cstdio>
#include <cstdint>
namespace cg = cooperative_groups;


typedef unsigned short u16;
using bf16x8 = __attribute__((ext_vector_type(8))) short;
using s16x4  = __attribute__((ext_vector_type(4))) short;
using f32x4  = __attribute__((ext_vector_type(4))) float;
using f32x16 = __attribute__((ext_vector_type(16))) float;
using u32x4  = __attribute__((ext_vector_type(4))) unsigned;
using u32x2  = __attribute__((ext_vector_type(2))) unsigned;
#define LAS __attribute__((address_space(3)))
#define GAS __attribute__((address_space(1)))

constexpr int DM = 1024, NTOK_P = 8192, NTOK_S = 32768, NTOK = 40960;
constexpr int SEQP = 256, SEQS = 4096, PAST = 256, KEYS_S = 4352;
constexpr int NTHREADS = 512;
constexpr int LDS_MAIN = 131072;
constexpr float LOG2E = 1.4426950408889634f;
constexpr float MLA_QS = 0.07216878364870322f * LOG2E;
constexpr float NA_QS = 0.125f * LOG2E;
constexpr float EPSN = 1e-6f;

constexpr size_t MiB = 1048576;
constexpr size_t WS_WT1 = 0;
constexpr size_t WS_WTQ = 5 * MiB;
constexpr size_t WS_WTV = 7 * MiB;
constexpr size_t WS_WTO = 9 * MiB;
constexpr size_t WS_WTN = 13 * MiB;
constexpr size_t WS_WTNO = 21 * MiB;
constexpr size_t WS_MOD = 23 * MiB;
constexpr size_t WS_KS = 24 * MiB;
constexpr size_t WS_KP = 37 * MiB;
constexpr size_t WS_CNK = 40 * MiB;
constexpr size_t WS_CNV = 44 * MiB;
constexpr size_t WS_BAR = 48 * MiB;
constexpr size_t WS_B = 64 * MiB;
constexpr size_t WS_C = 224 * MiB;
constexpr size_t WS_QN = 464 * MiB;
constexpr size_t WS_END = 484 * MiB;
constexpr size_t WS_GATE = WS_B;
constexpr size_t WS_Q = WS_C;
constexpr size_t WS_H = WS_C;
constexpr size_t WS_P1 = WS_C + 80 * MiB;
constexpr size_t WS_OSM = WS_C;
constexpr size_t WS_H1 = WS_B;
constexpr size_t WS_NG = WS_B + 80 * MiB;
constexpr size_t WS_NQ = WS_C;
constexpr size_t WS_NK = WS_C + 80 * MiB;
constexpr size_t WS_NV = WS_C + 160 * MiB;
constexpr size_t WS_OSM2 = WS_B;
constexpr size_t OUT_Y = 0, OUT_CKV = 41943040, OUT_KROPE = 42991616, OUT_NAK = 43515904, OUT_NAV = 51904512;

struct Params {
  const float *x_prompt, *x_sample, *c_ckv, *c_krope, *c_nak, *c_nav, *c, *c_ctx, *w_ada, *b_ada, *pre_g, *post_g;
  const float *w_in, *qg, *w_qb, *kvg, *w_kvb, *w_out, *na_w_in, *na_bias, *na_w_out;
  float* out; char* ws;
};

__device__ __forceinline__ u16 f2bf(float f) { unsigned u = __float_as_uint(f); u += 0x7fffu + ((u >> 16) & 1u); return (u16)(u >> 16); }
__device__ __forceinline__ float bf2f(u16 x) { return __uint_as_float(((unsigned)x) << 16); }
__device__ __forceinline__ unsigned cvtpk(float lo, float hi) {
  unsigned r; asm volatile("v_cvt_pk_bf16_f32 %0, %1, %2" : "=v"(r) : "v"(lo), "v"(hi)); return r;
}
__device__ __forceinline__ float siluf(float x) { return x / (1.f + __expf(-x)); }
__device__ __forceinline__ float wave_sum(float v) {
#pragma unroll
  for (int o = 32; o > 0; o >>= 1) v += __shfl_xor(v, o);
  return v;
}
__device__ __forceinline__ const float* xrow(const Params& p, int t) {
  return t < NTOK_P ? p.x_prompt + (size_t)t * DM : p.x_sample + (size_t)(t - NTOK_P) * DM;
}
__device__ __forceinline__ int modrow(int t) { return t < NTOK_P ? 0 : 1 + ((t - NTOK_P) >> 12); }
__device__ __forceinline__ int vblock() { int g = gridDim.x; return ((g & 7) == 0) ? (int)((blockIdx.x & 7) * (g >> 3) + (blockIdx.x >> 3)) : (int)blockIdx.x; }

constexpr int BM = 256, BK = 64, HALF = 128, HTB = HALF * BK * 2, NXCD = 8, WGM = 8;
__device__ __forceinline__ int lds_byte(int r, int c) { const int st = (r >> 4) * 2 + (c >> 5), rr = r & 15, cc = c & 31, ob = rr * 64 + cc * 2; return st * 1024 + (ob ^ (((ob >> 9) & 1) << 5)); }
__device__ __forceinline__ void stage_rc(int b, int& R, int& C) { const int st = b / 1024, sb = b % 1024, swz = sb ^ (((sb >> 9) & 1) << 5); R = (st >> 1) * 16 + swz / 64; C = (st & 1) * 32 + (swz % 64) / 2; }
__device__ __forceinline__ int perm32(int rho) { const int n = rho >> 4, i = rho & 15; return 8 * (i >> 2) + 4 * n + (i & 3); }
struct Unit { int pm, pn; };
struct StaticOrder {
  int nM, nN, nwg, G, c;
  __device__ void init(int M, int N, int G_, int c_) { nM = M / BM; nN = N / BM; nwg = nM * nN; G = G_; c = c_; }
  __device__ bool next(int i, Unit& u) const {
    const long L = (long)i * G + c; if (L >= nwg) return false;
    int wgid = (int)L; { const int q = nwg / NXCD, r = nwg % NXCD, xcd = wgid % NXCD, off = wgid / NXCD; wgid = (xcd < r ? xcd * (q + 1) : r * (q + 1) + (xcd - r) * q) + off; }
    const int nig = WGM * nN, gid = wgid / nig, fm = gid * WGM, gsz = (nM - fm) < WGM ? (nM - fm) : WGM;
    u.pm = fm + ((wgid % nig) % gsz); u.pn = (wgid % nig) / gsz; return true;
  }
};
struct GemmDesc { const u16* A; int lda; int a_pn_off; const u16* Bt; int ldb; int K; int nN; };

template <class E8>
__device__ __forceinline__ void gemm_phase(LAS unsigned char* lds, const GemmDesc g, const E8 E) {
  const int tid = threadIdx.x, wid = __builtin_amdgcn_readfirstlane(tid >> 6), lane = tid & 63, wr = wid >> 2, wc = wid & 3, fr = lane & 15, fq = lane >> 4;
  const int K = g.K, nt = K / BK;
  unsigned voffA[2], voffB[2];
#pragma unroll
  for (int i = 0; i < 2; ++i) { int R, C; stage_rc(tid * 16 + i * 8192, R, C); const int Rb = (R & ~31) + perm32(R & 31);
    voffA[i] = (unsigned)(R * g.lda + C) * 2u; voffB[i] = (unsigned)(Rb * g.ldb + C) * 2u; }
  const size_t kstep = (size_t)(BK * 2);
  const size_t hstepA = (size_t)HALF * g.lda * 2, hstepB = (size_t)HALF * g.ldb * 2;
  const size_t tstepA = 2 * hstepA, tstepB = 2 * hstepB, pnA = (size_t)g.a_pn_off * 2;
  const unsigned ldsw = (unsigned)wid * 1024u;
  const int aoff = lds_byte(wr * 64 + fr, fq * 8), boff = lds_byte(wc * 32 + fr, fq * 8);
#define PG8_SA(b, h) (((b) * 2 + (h)) * HTB)
#define PG8_SB(b, h) ((4 + (b) * 2 + (h)) * HTB)
#define PG8_STAGE(bufoff, gbase, voff) do { _Pragma("unroll") for (int _i = 0; _i < 2; ++_i) \
    __builtin_amdgcn_global_load_lds((const GAS unsigned*)((const char*)(gbase) + (voff)[_i]), (LAS unsigned*)(lds + (bufoff) + ldsw + _i * 8192), 16, 0, 0); } while (0)
#define PG8_LDA(dst, b, h) do { _Pragma("unroll") for (int m = 0; m < 4; ++m) _Pragma("unroll") for (int k = 0; k < 2; ++k) dst[m][k] = *(const LAS bf16x8*)(lds + PG8_SA(b, h) + aoff + m * 2048 + k * 1024); } while (0)
#define PG8_LDB(dst, b, h) do { _Pragma("unroll") for (int n = 0; n < 2; ++n) _Pragma("unroll") for (int k = 0; k < 2; ++k) dst[n][k] = *(const LAS bf16x8*)(lds + PG8_SB(b, h) + boff + n * 2048 + k * 1024); } while (0)
#define PG8_MMA(ai, bj, At, Bt_) do { __builtin_amdgcn_s_setprio(1); _Pragma("unroll") for (int m = 0; m < 4; ++m) _Pragma("unroll") for (int n = 0; n < 2; ++n) _Pragma("unroll") for (int k = 0; k < 2; ++k) \
    acc[ai][bj][m][n] = __builtin_amdgcn_mfma_f32_16x16x32_bf16(Bt_[n][k], At[m][k], acc[ai][bj][m][n], 0, 0, 0); __builtin_amdgcn_s_setprio(0); } while (0)
#define PG8_WAIT_V(n) asm volatile("s_waitcnt vmcnt(" #n ")" ::: "memory")
#define PG8_WAIT_L(n) asm volatile("s_waitcnt lgkmcnt(" #n ")" ::: "memory")
#define PG8_BAR __builtin_amdgcn_s_barrier()
#define PG8_SCHED __builtin_amdgcn_sched_barrier(0)
  StaticOrder S; S.init(NTOK, g.nN * BM, (int)gridDim.x, (int)blockIdx.x);
  Unit cur, nxt; int ui = 0;
  if (!S.next(0, cur)) return;
  f32x4 acc[2][2][4][2];
#pragma unroll
  for (int a = 0; a < 2; ++a)
#pragma unroll
    for (int b = 0; b < 2; ++b)
#pragma unroll
      for (int m = 0; m < 4; ++m)
#pragma unroll
        for (int n = 0; n < 2; ++n) acc[a][b][m][n] = (f32x4){0.f, 0.f, 0.f, 0.f};
  bf16x8 At[4][2], B0[2][2], B1[2][2];
  const char* cA = (const char*)g.A + (size_t)cur.pm * tstepA + (size_t)cur.pn * pnA; const char* cB = (const char*)g.Bt + (size_t)cur.pn * tstepB;
  PG8_STAGE(PG8_SB(0, 0), cB, voffB); PG8_STAGE(PG8_SA(0, 0), cA, voffA); PG8_STAGE(PG8_SB(0, 1), cB + hstepB, voffB); PG8_STAGE(PG8_SA(0, 1), cA + hstepA, voffA);
  if (wr == 1) PG8_BAR;
  PG8_WAIT_V(4); PG8_BAR;
  PG8_STAGE(PG8_SB(1, 0), cB + kstep, voffB); PG8_STAGE(PG8_SA(1, 0), cA + kstep, voffA); PG8_STAGE(PG8_SB(1, 1), cB + hstepB + kstep, voffB);
  PG8_WAIT_V(6); PG8_BAR;
  for (;;) {
    const bool has_next = S.next(ui + 1, nxt);
    const char* nA = has_next ? (const char*)g.A + (size_t)nxt.pm * tstepA + (size_t)nxt.pn * pnA : cA; const char* nB = has_next ? (const char*)g.Bt + (size_t)nxt.pn * tstepB : cB;
#pragma nounroll
    for (int t = 0; t < nt; t += 2) {
      const bool last = (t == nt - 2);
      const char* a1 = cA + (size_t)(t + 1) * kstep;
      const char* a2 = last ? nA : cA + (size_t)(t + 2) * kstep; const char* b2 = last ? nB : cB + (size_t)(t + 2) * kstep;
      const char* a3 = a2 + kstep; const char* b3 = b2 + kstep;
      PG8_LDB(B0, 0, 0); PG8_SCHED; PG8_LDA(At, 0, 0); PG8_STAGE(PG8_SA(1, 1), a1 + hstepA, voffA);
      PG8_WAIT_L(8); PG8_BAR; PG8_WAIT_L(0); PG8_MMA(0, 0, At, B0); PG8_BAR; PG8_SCHED;
      PG8_LDB(B1, 0, 1); PG8_STAGE(PG8_SB(0, 0), b2, voffB);
      PG8_BAR; PG8_WAIT_L(0); PG8_MMA(0, 1, At, B1); PG8_BAR;
      PG8_LDA(At, 0, 1); PG8_STAGE(PG8_SA(0, 0), a2, voffA);
      PG8_BAR; PG8_WAIT_L(0); PG8_MMA(1, 0, At, B0); PG8_BAR; PG8_SCHED;
      PG8_STAGE(PG8_SB(0, 1), b2 + hstepB, voffB);
      PG8_WAIT_V(6); PG8_BAR; PG8_MMA(1, 1, At, B1); PG8_BAR;
      PG8_LDB(B0, 1, 0); PG8_SCHED; PG8_LDA(At, 1, 0); PG8_STAGE(PG8_SA(0, 1), a2 + hstepA, voffA);
      PG8_WAIT_L(8); PG8_BAR; PG8_WAIT_L(0); PG8_MMA(0, 0, At, B0); PG8_BAR; PG8_SCHED;
      PG8_LDB(B1, 1, 1); PG8_STAGE(PG8_SB(1, 0), b3, voffB);
      PG8_BAR; PG8_WAIT_L(0); PG8_MMA(0, 1, At, B1); PG8_BAR;
      PG8_LDA(At, 1, 1); PG8_STAGE(PG8_SA(1, 0), a3, voffA);
      PG8_BAR; PG8_WAIT_L(0); PG8_MMA(1, 0, At, B0); PG8_BAR; PG8_SCHED;
      PG8_STAGE(PG8_SB(1, 1), b3 + hstepB, voffB);
      PG8_WAIT_V(6); PG8_BAR; PG8_MMA(1, 1, At, B1); PG8_BAR;
    }
    { const int row0 = cur.pm * BM + wr * 64 + fr, col0 = cur.pn * BM + wc * 32 + 8 * fq;
#pragma unroll
      for (int ai = 0; ai < 2; ++ai)
#pragma unroll
        for (int m = 0; m < 4; ++m)
#pragma unroll
          for (int bj = 0; bj < 2; ++bj) { E(row0 + ai * HALF + m * 16, col0 + bj * HALF, acc[ai][bj][m][0], acc[ai][bj][m][1]); if (E8::SERIAL) PG8_SCHED; } }
    if (!has_next) break;
#pragma unroll
    for (int a = 0; a < 2; ++a)
#pragma unroll
      for (int b = 0; b < 2; ++b)
#pragma unroll
        for (int m = 0; m < 4; ++m)
#pragma unroll
          for (int n = 0; n < 2; ++n) acc[a][b][m][n] = (f32x4){0.f, 0.f, 0.f, 0.f};
    cur = nxt; cA = nA; cB = nB; ++ui;
  }
  PG8_WAIT_V(0);
  if (wr == 0) PG8_BAR;
  PG8_BAR;
#undef PG8_SA
#undef PG8_SB
#undef PG8_STAGE
#undef PG8_LDA
#undef PG8_LDB
#undef PG8_MMA
#undef PG8_WAIT_V
#undef PG8_WAIT_L
#undef PG8_BAR
#undef PG8_SCHED
}

__device__ __forceinline__ u32x4 pack8(f32x4 a, f32x4 b) { u32x4 w = {cvtpk(a[0], a[1]), cvtpk(a[2], a[3]), cvtpk(b[0], b[1]), cvtpk(b[2], b[3])}; return w; }
__device__ __forceinline__ f32x4 silu4(f32x4 v) { f32x4 r = {siluf(v[0]), siluf(v[1]), siluf(v[2]), siluf(v[3])}; return r; }
__device__ __forceinline__ void unpack8(u32x4 w, f32x4& a, f32x4& b) {
  a[0] = __uint_as_float(w[0] << 16); a[1] = __uint_as_float(w[0] & 0xffff0000u); a[2] = __uint_as_float(w[1] << 16); a[3] = __uint_as_float(w[1] & 0xffff0000u);
  b[0] = __uint_as_float(w[2] << 16); b[1] = __uint_as_float(w[2] & 0xffff0000u); b[2] = __uint_as_float(w[3] << 16); b[3] = __uint_as_float(w[3] & 0xffff0000u);
}
struct EpiG1 {   static constexpr bool SERIAL = false;
  u16* gate; float* p1;
  __device__ __forceinline__ void operator()(int row, int col, f32x4 v0, f32x4 v1) const {
    if (col < 2048) { *reinterpret_cast<u32x4*>(gate + (size_t)row * 2048 + col) = pack8(silu4(v0), silu4(v1)); }
    else { int c = col - 2048; if (c < 448) { float* q = p1 + (size_t)row * 448 + c; *reinterpret_cast<f32x4*>(q) = v0; *reinterpret_cast<f32x4*>(q + 4) = v1; } }
  }
};
struct EpiG2 {   static constexpr bool SERIAL = true;
  u16* q;
  __device__ __forceinline__ void operator()(int row, int col, f32x4 v0, f32x4 v1) const {
    int j = col % 192;
    if (j >= 128 && row >= NTOK_P) {
      j -= 128; int n = (row - NTOK_P) & 4095; float pos = (float)((j & 32) ? (n & 63) : (n >> 6)); int f0 = (j & 31) >> 1;
#define ROT(X, Y, F) do { float inv = exp2f(-(float)(F) * (13.287712379549449f / 16.f)); float ang = pos * inv, cs = __cosf(ang), sn = __sinf(ang); \
        float o0 = X * cs - Y * sn, o1 = Y * cs + X * sn; X = o0; Y = o1; } while (0)
      ROT(v0[0], v0[1], f0); ROT(v0[2], v0[3], f0 + 1); ROT(v1[0], v1[1], f0 + 2); ROT(v1[2], v1[3], f0 + 3);
#undef ROT
    }
    *reinterpret_cast<u32x4*>(q + (size_t)row * 3072 + col) = pack8(v0 * MLA_QS, v1 * MLA_QS);
  }
};
struct EpiG3 {   static constexpr bool SERIAL = true;
  u16* g;
  __device__ __forceinline__ void operator()(int row, int col, f32x4 v0, f32x4 v1) const {
    u32x4* d = reinterpret_cast<u32x4*>(g + (size_t)row * 2048 + col); f32x4 g0, g1; unpack8(*d, g0, g1);
    *d = pack8(v0 * g0, v1 * g1);
  }
};
struct EpiStore {   static constexpr bool SERIAL = false;
  u16* o;
  __device__ __forceinline__ void operator()(int row, int col, f32x4 v0, f32x4 v1) const {
    *reinterpret_cast<u32x4*>(o + (size_t)row * 1024 + col) = pack8(v0, v1);
  }
};
struct EpiG5 {   static constexpr bool SERIAL = false;
  u16 *nq, *nk, *nv, *ng; float *sk, *sv;
  __device__ __forceinline__ void operator()(int row, int col, f32x4 v0, f32x4 v1) const {
    int sec = col >> 10, c = col & 1023; size_t o = (size_t)row * 1024 + c;
    if (sec == 0) { *reinterpret_cast<u32x4*>(nq + o) = pack8(v0 * NA_QS, v1 * NA_QS); }
    else if (sec == 1) { *reinterpret_cast<u32x4*>(nk + o) = pack8(v0, v1); if (row < NTOK_P) { *reinterpret_cast<f32x4*>(sk + o) = v0; *reinterpret_cast<f32x4*>(sk + o + 4) = v1; } }
    else if (sec == 2) { *reinterpret_cast<u32x4*>(nv + o) = pack8(v0, v1); if (row < NTOK_P) { *reinterpret_cast<f32x4*>(sv + o) = v0; *reinterpret_cast<f32x4*>(sv + o + 4) = v1; } }
    else { *reinterpret_cast<u32x4*>(ng + o) = pack8(silu4(v0), silu4(v1)); }
  }
};

#define KSWZ(row, colB) ((row) * 256 + ((colB) ^ (((row) & 15) << 4)))
#define RSWZ(row, colB) ((row) * 128 + ((colB) ^ ((((row) >> 1) & 7) << 4)))
#define SBAR() __builtin_amdgcn_sched_barrier(0)
constexpr float THRL = 11.5f;
__device__ __forceinline__ int crow(int r, int hi) { return (r & 3) + 8 * (r >> 2) + 4 * hi; }

__device__ __forceinline__ void partialSM(f32x16& p0, f32x16& p1, float& m_reg, float& mn, float& alpha) {
  float pmax = p0[0];
#pragma unroll
  for (int r = 1; r < 16; ++r) pmax = fmaxf(pmax, p0[r]);
#pragma unroll
  for (int r = 0; r < 16; ++r) pmax = fmaxf(pmax, p1[r]);
  { auto rr = __builtin_amdgcn_permlane32_swap(__float_as_uint(pmax), __float_as_uint(pmax), false, false);
    pmax = fmaxf(__uint_as_float(rr[0]), __uint_as_float(rr[1])); }
  if (__builtin_expect(__all(pmax - m_reg <= THRL), 1)) { mn = m_reg; alpha = 1.f; }
  else { mn = fmaxf(m_reg, pmax); alpha = __builtin_amdgcn_exp2f(m_reg - mn); m_reg = mn; }
#pragma unroll
  for (int r = 0; r < 16; ++r) p0[r] = p0[r] - mn;
#pragma unroll
  for (int r = 0; r < 16; ++r) p1[r] = p1[r] - mn;
#pragma unroll
  for (int r = 0; r < 16; ++r) p0[r] = __builtin_amdgcn_exp2f(p0[r]);
}
__device__ __forceinline__ void partialSM_pre(f32x16& p0, f32x16& p1, float& m_reg, float& alpha) {
  float pmax = p0[0];
#pragma unroll
  for (int r = 1; r < 16; ++r) pmax = fmaxf(pmax, p0[r]);
#pragma unroll
  for (int r = 0; r < 16; ++r) pmax = fmaxf(pmax, p1[r]);
  { auto rr = __builtin_amdgcn_permlane32_swap(__float_as_uint(pmax), __float_as_uint(pmax), false, false);
    pmax = fmaxf(__uint_as_float(rr[0]), __uint_as_float(rr[1])); }
  if (__builtin_expect(__all(pmax <= THRL), 1)) { alpha = 1.f; }
  else { const float d = fmaxf(pmax, 0.f); alpha = __builtin_amdgcn_exp2f(-d); m_reg += d;
#pragma unroll
    for (int r = 0; r < 16; ++r) { p0[r] -= d; p1[r] -= d; } }
#pragma unroll
  for (int r = 0; r < 16; ++r) p0[r] = __builtin_amdgcn_exp2f(p0[r]);
}
__device__ __forceinline__ void finishSM(f32x16& p0, f32x16& p1, float alpha, float& l_reg, bf16x8& pa0, bf16x8& pa1, bf16x8& pa2, bf16x8& pa3) {
#pragma unroll
  for (int r = 0; r < 16; ++r) p1[r] = __builtin_amdgcn_exp2f(p1[r]);
  float ps = 0;
#pragma unroll
  for (int r = 0; r < 16; ++r) ps += p0[r];
#pragma unroll
  for (int r = 0; r < 16; ++r) ps += p1[r];
  { auto rr = __builtin_amdgcn_permlane32_swap(__float_as_uint(ps), __float_as_uint(ps), false, false);
    ps = __uint_as_float(rr[0]) + __uint_as_float(rr[1]); }
  l_reg = l_reg * alpha + ps;
#define PK4(P, BASE, OUT) do { unsigned a0 = cvtpk(P[BASE + 0], P[BASE + 1]), a1 = cvtpk(P[BASE + 2], P[BASE + 3]);   \
    unsigned b0 = cvtpk(P[BASE + 4], P[BASE + 5]), b1 = cvtpk(P[BASE + 6], P[BASE + 7]);                              \
    auto r0 = __builtin_amdgcn_permlane32_swap(a0, b0, false, false); auto r1 = __builtin_amdgcn_permlane32_swap(a1, b1, false, false); \
    u32x4 w = {r0[0], r1[0], r0[1], r1[1]}; OUT = *reinterpret_cast<bf16x8*>(&w); } while (0)
  PK4(p0, 0, pa0); PK4(p0, 8, pa1); PK4(p1, 0, pa2); PK4(p1, 8, pa3);
#undef PK4
}
__device__ __forceinline__ void finishSM_np(f32x16& p0, f32x16& p1, float alpha, float& l_reg, bf16x8& pa0, bf16x8& pa1, bf16x8& pa2, bf16x8& pa3) {
#pragma unroll
  for (int r = 0; r < 16; ++r) p1[r] = __builtin_amdgcn_exp2f(p1[r]);
  float ps = 0;
#pragma unroll
  for (int r = 0; r < 16; ++r) ps += p0[r];
#pragma unroll
  for (int r = 0; r < 16; ++r) ps += p1[r];
  { auto rr = __builtin_amdgcn_permlane32_swap(__float_as_uint(ps), __float_as_uint(ps), false, false);
    ps = __uint_as_float(rr[0]) + __uint_as_float(rr[1]); }
  l_reg = l_reg * alpha + ps;
#define PKN(P, BASE, OUT) do { u32x4 w = {cvtpk(P[BASE + 0], P[BASE + 1]), cvtpk(P[BASE + 2], P[BASE + 3]), cvtpk(P[BASE + 4], P[BASE + 5]), cvtpk(P[BASE + 6], P[BASE + 7])}; \
    OUT = *reinterpret_cast<bf16x8*>(&w); } while (0)
  PKN(p0, 0, pa0); PKN(p0, 8, pa1); PKN(p1, 0, pa2); PKN(p1, 8, pa3);
#undef PKN
}
__device__ __forceinline__ int v_rd_base(int lane) { return ((lane & 3) << 3) | (((lane >> 2) & 3) << 6) | (((lane >> 4) & 1) << 5) | (((lane >> 5) & 1) << 8); }
template <int OFF> __device__ __forceinline__ s16x4 tr_read(int vb) {
  s16x4 r; asm volatile("ds_read_b64_tr_b16 %0, %1 offset:%2" : "=&v"(r) : "v"(vb), "i"(OFF) : "memory"); return r;
}
template <int NCB, bool SWAP = true> __device__ __forceinline__ int v_st(int k, int c) {
  const int kk = SWAP ? ((k & ~0xC) | ((k & 4) << 1) | ((k & 8) >> 1)) : k;
  return ((kk >> 3) * NCB + (c >> 5)) * 512 + ((kk & 7) * 32 + (c & 31)) * 2;
}
template <int NCB, int D0> __device__ __forceinline__ void pv_one(f32x16& od, int vb, bf16x8 pa0, bf16x8 pa1, bf16x8 pa2, bf16x8 pa3) {
  constexpr int KS = NCB * 1024, HF = NCB * 512;
  const s16x4 l0 = tr_read<D0 * 512 + 0 * KS>(vb), h0 = tr_read<D0 * 512 + 0 * KS + HF>(vb), l1 = tr_read<D0 * 512 + 1 * KS>(vb), h1 = tr_read<D0 * 512 + 1 * KS + HF>(vb);
  const s16x4 l2 = tr_read<D0 * 512 + 2 * KS>(vb), h2 = tr_read<D0 * 512 + 2 * KS + HF>(vb), l3 = tr_read<D0 * 512 + 3 * KS>(vb), h3 = tr_read<D0 * 512 + 3 * KS + HF>(vb);
  asm volatile("s_waitcnt lgkmcnt(0)" ::: "memory"); SBAR();
#define PK(L, H) (bf16x8){L[0], L[1], L[2], L[3], H[0], H[1], H[2], H[3]}
  od = __builtin_amdgcn_mfma_f32_32x32x16_bf16(PK(l0, h0), pa0, od, 0, 0, 0);
  od = __builtin_amdgcn_mfma_f32_32x32x16_bf16(PK(l1, h1), pa1, od, 0, 0, 0);
  od = __builtin_amdgcn_mfma_f32_32x32x16_bf16(PK(l2, h2), pa2, od, 0, 0, 0);
  od = __builtin_amdgcn_mfma_f32_32x32x16_bf16(PK(l3, h3), pa3, od, 0, 0, 0);
#undef PK
}

constexpr int M_SHM_V = 16384, M_SHM_KN = 16384, M_SHM_KR = 8192;
constexpr int M_OFF_V = 0, M_OFF_KN = 32768, M_OFF_KR = 65536, M_OFF_WS = 81920;

template <int OFF> __device__ __forceinline__ bf16x8 lds_r128(int a) {
  bf16x8 r; asm volatile("ds_read_b128 %0, %1 offset:%2" : "=&v"(r) : "v"(a), "i"(OFF) : "memory"); return r;
}
#define LGKM_WAIT(n) do { asm volatile("s_waitcnt lgkmcnt(" #n ")" ::: "memory"); SBAR(); } while (0)
constexpr int M_TILE = 40960;
constexpr int M_OFF_WS3 = 3 * M_TILE;
template <int VAR>
__device__ __forceinline__ void mla_attn_body(const u16* __restrict__ Qb, const u16* __restrict__ Kh, int seq, char* lds,
                                              const u16* __restrict__ WvT, u16* __restrict__ Gq) {
  constexpr int LDQ = 3072, LDK = 192;
  const int tid = threadIdx.x, wid = tid >> 6, lane = tid & 63, r32 = lane & 31, hi = lane >> 5, grp = (wid & 1) ^ (wid >> 2);
  float m_reg = -1e30f, l_reg = 0; f32x16 o[4] = {}; bf16x8 qr[12];
  const u16* Qw = Qb + (long)(wid * 32 + r32) * LDQ + hi * 8;
#pragma unroll
  for (int d0 = 0; d0 < 12; ++d0) qr[d0] = *reinterpret_cast<const bf16x8*>(Qw + d0 * 16);
  const int vb0 = (int)(uintptr_t)(LAS char*)lds + v_rd_base(lane);
  const int widu = __builtin_amdgcn_readfirstlane(wid);
  int ov0, ov1, okn0, okn1, okr;
  { auto vsrc = [&](int chunk) { const int sub = chunk * 2 + (lane >> 5), kk = (sub >> 2) * 8 + ((lane & 31) >> 2);
      const int k = kk, c = (sub & 3) * 32 + (lane & 3) * 8; return (k * LDK + c) * 2; };
    auto knsrc = [&](int chunk) { const int row = chunk * 4 + (lane >> 4), slot = (lane & 15) ^ (row & 15); return (row * LDK + slot * 8) * 2; };
    ov0 = vsrc(widu * 2); ov1 = vsrc(widu * 2 + 1); okn0 = knsrc(widu * 2); okn1 = knsrc(widu * 2 + 1);
    const int row = widu * 8 + (lane >> 3), slot = (lane & 7) ^ ((row >> 1) & 7); okr = (row * LDK + 128 + slot * 8) * 2; }
  LAS char* const l3 = (LAS char*)lds;
#define GL_LDS(g, l) __builtin_amdgcn_global_load_lds((const GAS unsigned*)(g), (LAS unsigned*)(l), 16, 0, 0)
#define DMA(boff, k0) do { const char* tb_ = (const char*)(Kh + (long)(k0) * LDK); LAS char* lb_ = l3 + (boff) + widu * 2048;   \
    GL_LDS(tb_ + ov0, lb_); GL_LDS(tb_ + ov1, lb_ + 1024); GL_LDS(tb_ + okn0, lb_ + 16384); GL_LDS(tb_ + okn1, lb_ + 16384 + 1024); \
    GL_LDS(tb_ + okr, l3 + (boff) + 32768 + widu * 1024); } while (0)
#define VM_WAIT0() asm volatile("s_waitcnt vmcnt(0)" ::: "memory")
#define RESC(a) do { if (__any((a) < 1.f)) { for (int d = 0; d < 4; ++d) for (int r = 0; r < 16; ++r) o[d][r] *= (a); } } while (0)
#define PBAR() do { asm volatile("s_waitcnt lgkmcnt(0)" ::: "memory"); __builtin_amdgcn_s_barrier(); asm volatile("" ::: "memory"); } while (0)
  const int NT = seq / 64;
  int dummy_store = 0; if constexpr (VAR != 0) { asm volatile("s_mov_b32 %0, 0" : "=s"(dummy_store)); }
  f32x16 p0, p1; float mn, al; bf16x8 pa0, pa1, pa2, pa3;
  constexpr int QD = 2;
  bf16x8 fa0, fb0, fa1, fb1;
#define RDK(s, FA, FB) do { if ((s) < 8) { int a_ = bK + ((((s) * 32) + hi_ * 16) ^ fK); FA = lds_r128<0>(a_); FB = lds_r128<8192>(a_); }   \
                            else { int a_ = bR + (((((s) - 8) * 32) + hi_ * 16) ^ fR); FA = lds_r128<0>(a_); FB = lds_r128<4096>(a_); } } while (0)
#define STEP(s, FA, FB, W) do { LGKM_WAIT(W); p0 = __builtin_amdgcn_mfma_f32_32x32x16_bf16(FA, qr[s], p0, 0, 0, 0);         \
                                p1 = __builtin_amdgcn_mfma_f32_32x32x16_bf16(FB, qr[s], p1, 0, 0, 0); } while (0)
#define QK_ADDR(boff) int r32_ = r32, hi_ = hi; asm volatile("" : "+v"(r32_), "+v"(hi_));                                    \
    const int fK = (r32_ & 15) << 4, fR = ((r32_ >> 1) & 7) << 4;                                                             \
    const int bK = ldsb + (boff) + 16384 + r32_ * 256, bR = ldsb + (boff) + 32768 + r32_ * 128;
#define QK_HEAD() do { RDK(0, fa0, fb0); RDK(1, fa1, fb1); } while (0)
#define QK_STEPS(SEED) do { { const float sd_ = (SEED); for (int r_ = 0; r_ < 16; ++r_) { p0[r_] = sd_; p1[r_] = sd_; } }                                                                        \
    STEP(0, fa0, fb0, 2); RDK(2, fa0, fb0); STEP(1, fa1, fb1, 2); RDK(3, fa1, fb1); STEP(2, fa0, fb0, 2); RDK(4, fa0, fb0);   \
    STEP(3, fa1, fb1, 2); RDK(5, fa1, fb1); STEP(4, fa0, fb0, 2); RDK(6, fa0, fb0); STEP(5, fa1, fb1, 2); RDK(7, fa1, fb1);   \
    STEP(6, fa0, fb0, 2); RDK(8, fa0, fb0); STEP(7, fa1, fb1, 2); RDK(9, fa1, fb1); STEP(8, fa0, fb0, 2); RDK(10, fa0, fb0);  \
    STEP(9, fa1, fb1, 2); RDK(11, fa1, fb1); STEP(10, fa0, fb0, 2); STEP(11, fa1, fb1, 0); } while (0)
  s16x4 tl0, th0, tl1, th1, tl2, th2, tl3, th3, ul0, uh0, ul1, uh1, ul2, uh2, ul3, uh3;
#define TRG(D0, P, vb) do { P##l0 = tr_read<D0 * 512>(vb); P##h0 = tr_read<D0 * 512 + 2048>(vb); P##l1 = tr_read<D0 * 512 + 4096>(vb); P##h1 = tr_read<D0 * 512 + 6144>(vb);      \
    P##l2 = tr_read<D0 * 512 + 8192>(vb); P##h2 = tr_read<D0 * 512 + 10240>(vb); P##l3 = tr_read<D0 * 512 + 12288>(vb); P##h3 = tr_read<D0 * 512 + 14336>(vb); } while (0)
#define PK(L, H) (bf16x8){L[0], L[1], L[2], L[3], H[0], H[1], H[2], H[3]}
#define PVM(od, P) do { od = __builtin_amdgcn_mfma_f32_32x32x16_bf16(PK(P##l0, P##h0), pa0, od, 0, 0, 0); od = __builtin_amdgcn_mfma_f32_32x32x16_bf16(PK(P##l1, P##h1), pa1, od, 0, 0, 0); \
    od = __builtin_amdgcn_mfma_f32_32x32x16_bf16(PK(P##l2, P##h2), pa2, od, 0, 0, 0); od = __builtin_amdgcn_mfma_f32_32x32x16_bf16(PK(P##l3, P##h3), pa3, od, 0, 0, 0); } while (0)
  const int ldsb = (int)(uintptr_t)(LAS char*)lds;
  DMA(0, 0); VM_WAIT0();
  __syncthreads();
  if (grp == 1) PBAR();
  if (1 < NT) DMA(M_TILE, 64);
  { QK_ADDR(0); QK_HEAD(); QK_STEPS(0.f); }
  VM_WAIT0(); PBAR();
  int bc = 0, bn = M_TILE, bw = 2 * M_TILE;
  for (int j = 0; j < NT; ++j) {
    if constexpr (VAR == 3) { al = 1.f; mn = 0.f;
      { unsigned a0 = cvtpk(p0[0], p0[1]), a1 = cvtpk(p0[2], p0[3]), a2 = cvtpk(p0[4], p0[5]), a3 = cvtpk(p0[6], p0[7]); u32x4 w = {a0, a1, a2, a3}; pa0 = *reinterpret_cast<bf16x8*>(&w); }
      { unsigned a0 = cvtpk(p0[8], p0[9]), a1 = cvtpk(p0[10], p0[11]), a2 = cvtpk(p0[12], p0[13]), a3 = cvtpk(p0[14], p0[15]); u32x4 w = {a0, a1, a2, a3}; pa1 = *reinterpret_cast<bf16x8*>(&w); }
      { unsigned a0 = cvtpk(p1[0], p1[1]), a1 = cvtpk(p1[2], p1[3]), a2 = cvtpk(p1[4], p1[5]), a3 = cvtpk(p1[6], p1[7]); u32x4 w = {a0, a1, a2, a3}; pa2 = *reinterpret_cast<bf16x8*>(&w); }
      { unsigned a0 = cvtpk(p1[8], p1[9]), a1 = cvtpk(p1[10], p1[11]), a2 = cvtpk(p1[12], p1[13]), a3 = cvtpk(p1[14], p1[15]); u32x4 w = {a0, a1, a2, a3}; pa3 = *reinterpret_cast<bf16x8*>(&w); }
      l_reg += p0[0];
    } else {
    if (j == 0) partialSM(p0, p1, m_reg, mn, al); else partialSM_pre(p0, p1, m_reg, al);
    RESC(al);
    finishSM_np(p0, p1, al, l_reg, pa0, pa1, pa2, pa3);
    }
    const int vb = vb0 + bc;
    SBAR(); TRG(0, t, vb);
    PBAR();
    __builtin_amdgcn_s_setprio(1);
    if (j + 2 < NT) DMA(bw, (j + 2) * 64);
    SBAR();
    TRG(1, u, vb);
    PVM(o[0], t);
    TRG(2, t, vb); LGKM_WAIT(8);
    PVM(o[1], u);
    TRG(3, u, vb); LGKM_WAIT(8);
    PVM(o[2], t);
    if (j + 1 < NT) {
      QK_ADDR(bn); QK_HEAD(); LGKM_WAIT(4);
      PVM(o[3], u);
      QK_STEPS(-m_reg);
    } else { LGKM_WAIT(0); PVM(o[3], u); }
    __builtin_amdgcn_s_setprio(0);
    VM_WAIT0(); PBAR();
    { int t_ = bc; bc = bn; bn = bw; bw = t_; }
  }
  if (grp == 0) PBAR();
  { const float rl = __builtin_amdgcn_rcpf(l_reg);
    bf16x8 ob[8];
#pragma unroll
    for (int ks = 0; ks < 8; ++ks) { const int d0 = ks >> 1, t8 = (ks & 1) * 8;
      u32x4 w = {cvtpk(o[d0][t8 + 0] * rl, o[d0][t8 + 1] * rl), cvtpk(o[d0][t8 + 2] * rl, o[d0][t8 + 3] * rl),
                 cvtpk(o[d0][t8 + 4] * rl, o[d0][t8 + 5] * rl), cvtpk(o[d0][t8 + 6] * rl, o[d0][t8 + 7] * rl)};
      ob[ks] = *reinterpret_cast<bf16x8*>(&w); }
    const u16* WT = WvT + (long)r32 * 128 + hi * 4;
    u16* Gw = Gq + (long)(wid * 32 + r32) * 2048 + hi * 4;
    u32x2 wl[4][8][2];
#pragma unroll
    for (int nb = 0; nb < 4; ++nb)
#pragma unroll
      for (int ks = 0; ks < 8; ++ks) { const u16* wp = WT + nb * 32 * 128 + ks * 16;
        wl[nb][ks][0] = *reinterpret_cast<const u32x2*>(wp); wl[nb][ks][1] = *reinterpret_cast<const u32x2*>(wp + 8); }
#pragma unroll
    for (int nb = 0; nb < 4; ++nb) {
      f32x16 c = {};
#pragma unroll
      for (int ks = 0; ks < 8; ++ks) { u32x4 w = {wl[nb][ks][0][0], wl[nb][ks][0][1], wl[nb][ks][1][0], wl[nb][ks][1][1]};
        c = __builtin_amdgcn_mfma_f32_32x32x16_bf16(*reinterpret_cast<bf16x8*>(&w), ob[ks], c, 0, 0, 0); }
#pragma unroll
      for (int g = 0; g < 4; ++g) { u32x2* dp = reinterpret_cast<u32x2*>(Gw + nb * 32 + g * 8); u32x2 gv = *dp;
        float g0 = __uint_as_float(gv[0] << 16), g1 = __uint_as_float(gv[0] & 0xffff0000u), g2 = __uint_as_float(gv[1] << 16), g3 = __uint_as_float(gv[1] & 0xffff0000u);
        u32x2 wv = {cvtpk(c[g * 4 + 0] * g0, c[g * 4 + 1] * g1), cvtpk(c[g * 4 + 2] * g2, c[g * 4 + 3] * g3)};
        if (VAR == 0 || dummy_store) *dp = wv; }
    }
  }
  __syncthreads();
#undef GL_LDS
#undef DMA
#undef VM_WAIT0
#undef RESC
#undef PBAR
#undef RDK
#undef STEP
#undef QK_ADDR
#undef QK_HEAD
#undef QK_STEPS
#undef TRG
#undef PK
#undef PVM
}

constexpr int N_SHM = 8192;
constexpr int N_OFF_V = 0, N_OFF_K = 16384, N_OFF_TBL = 32768, N_OFF_WS = 36864;

__device__ __forceinline__ void na_qkt(f32x16& p0, f32x16& p1, const char* Kr, const bf16x8* qr, int r32, int hi, float seed) {
#pragma unroll
  for (int r = 0; r < 16; ++r) { p0[r] = seed; p1[r] = seed; }
#pragma unroll
  for (int d0 = 0; d0 < 4; ++d0) { int cb = (d0 * 16 + hi * 8) * 2;
    bf16x8 b0 = *reinterpret_cast<const bf16x8*>(Kr + RSWZ(r32, cb));
    bf16x8 b1 = *reinterpret_cast<const bf16x8*>(Kr + RSWZ(32 + r32, cb));
    p0 = __builtin_amdgcn_mfma_f32_32x32x16_bf16(b0, qr[d0], p0, 0, 0, 0);
    p1 = __builtin_amdgcn_mfma_f32_32x32x16_bf16(b1, qr[d0], p1, 0, 0, 0); }
}
__device__ __forceinline__ void na_pv(f32x16* o, int vb, bf16x8 pa0, bf16x8 pa1, bf16x8 pa2, bf16x8 pa3) {
  pv_one<2, 0>(o[0], vb, pa0, pa1, pa2, pa3); pv_one<2, 1>(o[1], vb, pa0, pa1, pa2, pa3);
}
__device__ __forceinline__ void na_mask(f32x16& p0, f32x16& p1, const float* bp, unsigned m0, unsigned m1) {
#pragma unroll
  for (int r = 0; r < 16; ++r) {
    const int kc = (r & 3) + 8 * (r >> 2);
    float b0 = bp[kc], b1 = bp[kc + 32];
    p0[r] = ((m0 >> r) & 1u) ? p0[r] + b0 : -INFINITY;
    p1[r] = ((m1 >> r) & 1u) ? p1[r] + b1 : -INFINITY;
  }
}

template <unsigned L0, unsigned L1>
__device__ __forceinline__ void na_mask_t(f32x16& p0, f32x16& p1, const float* bp, unsigned m0, unsigned m1) {
#pragma unroll
  for (int r = 0; r < 16; ++r) {
    const int kc = (r & 3) + 8 * (r >> 2);
    if ((L0 >> r) & 1u) { float b0 = bp[kc]; p0[r] = ((m0 >> r) & 1u) ? p0[r] + b0 : -INFINITY; }
    if ((L1 >> r) & 1u) { float b1 = bp[kc + 32]; p1[r] = ((m1 >> r) & 1u) ? p1[r] + b1 : -INFINITY; }
  }
}
template <unsigned L0, unsigned L1>
__device__ __forceinline__ void partialSM_pre_t(f32x16& p0, f32x16& p1, float& m_reg, float& alpha) {
  float pmax = -INFINITY;
#pragma unroll
  for (int r = 0; r < 16; ++r) { if ((L0 >> r) & 1u) pmax = fmaxf(pmax, p0[r]); }
#pragma unroll
  for (int r = 0; r < 16; ++r) { if ((L1 >> r) & 1u) pmax = fmaxf(pmax, p1[r]); }
  { auto rr = __builtin_amdgcn_permlane32_swap(__float_as_uint(pmax), __float_as_uint(pmax), false, false);
    pmax = fmaxf(__uint_as_float(rr[0]), __uint_as_float(rr[1])); }
  if (__builtin_expect(__all(pmax <= THRL), 1)) { alpha = 1.f; }
  else { const float d = fmaxf(pmax, 0.f); alpha = __builtin_amdgcn_exp2f(-d); m_reg += d;
#pragma unroll
    for (int r = 0; r < 16; ++r) { if ((L0 >> r) & 1u) p0[r] -= d; if ((L1 >> r) & 1u) p1[r] -= d; } }
#pragma unroll
  for (int r = 0; r < 16; ++r) { if ((L0 >> r) & 1u) p0[r] = __builtin_amdgcn_exp2f(p0[r]); }
}
template <unsigned L0, unsigned L1>
__device__ __forceinline__ void finishSM_np_t(f32x16& p0, f32x16& p1, float alpha, float& l_reg, bf16x8& pa0, bf16x8& pa1, bf16x8& pa2, bf16x8& pa3) {
#pragma unroll
  for (int r = 0; r < 16; ++r) { if ((L1 >> r) & 1u) p1[r] = __builtin_amdgcn_exp2f(p1[r]); }
  float ps = 0;
#pragma unroll
  for (int r = 0; r < 16; ++r) { if ((L0 >> r) & 1u) ps += p0[r]; }
#pragma unroll
  for (int r = 0; r < 16; ++r) { if ((L1 >> r) & 1u) ps += p1[r]; }
  { auto rr = __builtin_amdgcn_permlane32_swap(__float_as_uint(ps), __float_as_uint(ps), false, false);
    ps = __uint_as_float(rr[0]) + __uint_as_float(rr[1]); }
  l_reg = l_reg * alpha + ps;
#define PV_(P, L, R) ((((L) >> (R)) & 1u) ? P[R] : 0.f)
#define PKT(P, L, BASE, OUT) do { if ((((L) >> (BASE)) & 0xFFu) == 0u) { OUT = bf16x8{}; } else {                                  \
    u32x4 w = {cvtpk(PV_(P, L, BASE + 0), PV_(P, L, BASE + 1)), cvtpk(PV_(P, L, BASE + 2), PV_(P, L, BASE + 3)),                       \
               cvtpk(PV_(P, L, BASE + 4), PV_(P, L, BASE + 5)), cvtpk(PV_(P, L, BASE + 6), PV_(P, L, BASE + 7))};                       \
    OUT = *reinterpret_cast<bf16x8*>(&w); } } while (0)
  PKT(p0, L0, 0, pa0); PKT(p0, L0, 8, pa1); PKT(p1, L1, 0, pa2); PKT(p1, L1, 8, pa3);
#undef PKT
#undef PV_
}

template <bool RW>
__device__ __forceinline__ void na_attn_body_t(const u16* __restrict__ Qb, const u16* __restrict__ Kc, const u16* __restrict__ Vc,
                                             const u16* __restrict__ Kl, const u16* __restrict__ Vl, int nctx, int NT, int lo,
                                             bool masked, int r0, u16* __restrict__ G, char* lds) {
  constexpr int LD = 1024;
  const int tid = threadIdx.x, wid = tid >> 6, lane = tid & 63, r32 = lane & 31, hi = lane >> 5;
  char* V_lds = lds + N_OFF_V; char* K_lds = lds + N_OFF_K; const float* tbl = (const float*)(lds + N_OFF_TBL);
  float m_reg = -1e30f, l_reg = 0; f32x16 o[2] = {}; bf16x8 qr[4];
  const u16* Qw = Qb + (long)(wid * 32 + r32) * LD + hi * 8;
#pragma unroll
  for (int d0 = 0; d0 < 4; ++d0) qr[d0] = *reinterpret_cast<const bf16x8*>(Qw + d0 * 16);
  const int rr = tid >> 3, rc = (tid & 7) * 8, vst = v_st<2, false>(rr, rc);
  const int vb0 = (int)(uintptr_t)(LAS char*)V_lds + v_rd_base(lane);
  const int rq = r0 + (wid >> 1), cq = (wid & 1) * 32 + r32;
  unsigned m0 = 0, m1 = 0;
  { const int cs = min(max(cq - 8, 0), 48);
#pragma unroll
    for (int r = 0; r < 16; ++r) { int kc = crow(r, hi); m0 |= ((unsigned)(kc - cs) < 16u ? 1u : 0u) << r; m1 |= ((unsigned)(kc + 32 - cs) < 16u ? 1u : 0u) << r; } }
  const float* tbase = tbl + (15 - cq + 4 * hi);
  struct { bf16x8 k, v; } sr_[2];
#define TILEK(j) (((j) < nctx) ? (Kc + (long)(j) * 64 * LD) : (Kl + (long)(lo + (j) - nctx) * 64 * LD))
#define TILEV(j) (((j) < nctx) ? (Vc + (long)(j) * 64 * LD) : (Vl + (long)(lo + (j) - nctx) * 64 * LD))
#define SLOAD(i, j) do { sr_[i].k = *reinterpret_cast<const bf16x8*>(TILEK(j) + (long)rr * LD + rc);  \
    sr_[i].v = *reinterpret_cast<const bf16x8*>(TILEV(j) + (long)rr * LD + rc); } while (0)
#define SWRITE(b, i) do { *(bf16x8*)(V_lds + (b) * N_SHM + vst) = sr_[i].v; *(bf16x8*)(K_lds + (b) * N_SHM + RSWZ(rr, rc * 2)) = sr_[i].k; } while (0)
#define SWAIT() asm volatile("s_waitcnt vmcnt(2)" ::: "memory")
#define RESC(a) do { if (__any((a) < 1.f)) { for (int d = 0; d < 2; ++d) for (int r = 0; r < 16; ++r) o[d][r] *= (a); } } while (0)
  constexpr unsigned LL0 = RW ? 0xF000u : 0xFFFFu, LL1 = RW ? 0xFFFFu : 0x000Fu;
#define MASK_C(P0, P1, j) do { } while (0)
#define MASK_L(P0, P1, j) na_mask_t<LL0, LL1>(P0, P1, tbase + (lo + (j) - nctx - rq + 7) * 31, m0, m1)
#define SMPRE_C(P0, P1, AL) partialSM_pre(P0, P1, m_reg, AL)
#define SMPRE_L(P0, P1, AL) partialSM_pre_t<LL0, LL1>(P0, P1, m_reg, AL)
#define SMFIN_C(P0, P1, AL) finishSM_np(P0, P1, AL, l_reg, pa0, pa1, pa2, pa3)
#define SMFIN_L(P0, P1, AL) finishSM_np_t<LL0, LL1>(P0, P1, AL, l_reg, pa0, pa1, pa2, pa3)
  f32x16 pA0, pA1, pB0, pB1; float mnA, mnB, alA = 1.f, alB = 1.f; bf16x8 pa0, pa1, pa2, pa3;
  const int rs_w = __builtin_amdgcn_readfirstlane(min(max(r0 + (wid >> 1) - 4, 0), 56));
#define VALID(j) (!masked || (j) < nctx || ((unsigned)(lo + (j) - nctx - rs_w) < 8u))
  bool vA = true, vB = true;
  SLOAD(0, 0); asm volatile("s_waitcnt vmcnt(0)" ::: "memory"); SWRITE(0, 0); __syncthreads();
  vA = VALID(0);
  if (vA) { na_qkt(pA0, pA1, K_lds, qr, r32, hi, 0.f); partialSM(pA0, pA1, m_reg, mnA, alA); }
  SLOAD(1, 1); if (2 < NT) SLOAD(0, 2);
  SWAIT(); SWRITE(1, 1); __syncthreads();
#define ITER(j, FA, KB, KA) do {                                                                                   \
    vB = VALID(j);                                                                                                 \
    SBAR(); if (vB) { na_qkt(pB0, pB1, K_lds + N_SHM, qr, r32, hi, -m_reg); MASK_##KB(pB0, pB1, j); }               \
    if (vA) SMFIN_##FA(pA0, pA1, alA);                                                                             \
    SBAR();                                                                                                        \
    SLOAD(1, (j) + 2); SBAR();                                                                                     \
    if (vA) na_pv(o, vb0, pa0, pa1, pa2, pa3);                                                                     \
    if (vB) SMPRE_##KB(pB0, pB1, alB); else alB = 1.f;                                                             \
    __syncthreads(); SWAIT(); SWRITE(0, 0);                                                                        \
    RESC(alB); __syncthreads();                                                                                    \
    vA = VALID((j) + 1);                                                                                           \
    SBAR(); if (vA) { na_qkt(pA0, pA1, K_lds, qr, r32, hi, -m_reg); MASK_##KA(pA0, pA1, (j) + 1); }                 \
    if (vB) SMFIN_##KB(pB0, pB1, alB);                                                                             \
    SBAR();                                                                                                        \
    if ((j) + 3 < NT) SLOAD(0, (j) + 3); SBAR();                                                                   \
    if (vB) na_pv(o, vb0 + N_SHM, pa0, pa1, pa2, pa3);                                                             \
    if (vA) SMPRE_##KA(pA0, pA1, alA); else alA = 1.f;                                                             \
    __syncthreads(); SWAIT(); SWRITE(1, 1);                                                                        \
    RESC(alA); __syncthreads(); } while (0)
#define TAIL(FA, KB) do {                                                                                          \
    vB = VALID(NT - 1);                                                                                            \
    SBAR(); if (vB) { na_qkt(pB0, pB1, K_lds + N_SHM, qr, r32, hi, -m_reg); MASK_##KB(pB0, pB1, NT - 1); }          \
    if (vA) SMFIN_##FA(pA0, pA1, alA);                                                                             \
    SBAR();                                                                                                        \
    if (vA) na_pv(o, vb0, pa0, pa1, pa2, pa3);                                                                     \
    if (vB) SMPRE_##KB(pB0, pB1, alB); else alB = 1.f;                                                             \
    __syncthreads(); RESC(alB);                                                                                    \
    if (vB) { SMFIN_##KB(pB0, pB1, alB); SBAR(); na_pv(o, vb0 + N_SHM, pa0, pa1, pa2, pa3); } } while (0)
  if (!masked) {
    ITER(1, C, C, C);
    TAIL(C, C);
  } else {
    ITER(1, C, C, C);
    ITER(3, C, C, L);
    for (int j = 5; j + 1 < NT; j += 2) ITER(j, L, L, L);
    TAIL(L, L);
  }
#undef ITER
#undef TAIL
  { const float rl = __builtin_amdgcn_rcpf(l_reg);
    u16* Ow = G + (long)(wid * 32 + r32) * LD + hi * 4;
#pragma unroll
    for (int d0 = 0; d0 < 2; ++d0)
#pragma unroll
      for (int g = 0; g < 4; ++g) { u32x2* dp = reinterpret_cast<u32x2*>(Ow + d0 * 32 + g * 8); u32x2 gv = *dp;
        float g0 = __uint_as_float(gv[0] << 16), g1 = __uint_as_float(gv[0] & 0xffff0000u), g2 = __uint_as_float(gv[1] << 16), g3 = __uint_as_float(gv[1] & 0xffff0000u);
        u32x2 w = {cvtpk(o[d0][g * 4 + 0] * rl * g0, o[d0][g * 4 + 1] * rl * g1), cvtpk(o[d0][g * 4 + 2] * rl * g2, o[d0][g * 4 + 3] * rl * g3)};
        *dp = w; } }
  __syncthreads();
#undef TILEK
#undef TILEV
#undef SLOAD
#undef SWRITE
#undef SWAIT
#undef RESC
#undef VALID
#undef MASK_C
#undef MASK_L
#undef SMPRE_C
#undef SMPRE_L
#undef SMFIN_C
#undef SMFIN_L
}

__device__ __forceinline__ void na_attn_body(const u16* __restrict__ Qb, const u16* __restrict__ Kc, const u16* __restrict__ Vc,
                                             const u16* __restrict__ Kl, const u16* __restrict__ Vl, int nctx, int NT, int lo,
                                             bool masked, int r0, u16* __restrict__ G, char* lds) {
  if (__builtin_amdgcn_readfirstlane((int)(threadIdx.x >> 6)) & 1) na_attn_body_t<true>(Qb, Kc, Vc, Kl, Vl, nctx, NT, lo, masked, r0, G, lds);
  else na_attn_body_t<false>(Qb, Kc, Vc, Kl, Vl, nctx, NT, lo, masked, r0, G, lds);
}

__device__ __forceinline__ int rope_phys(int nn) { return (nn & 32) | ((nn & 15) << 1) | ((nn >> 4) & 1); }
__device__ __forceinline__ void tr_tile(const float* __restrict__ src, int lds_, int k0, int n0, u16* __restrict__ dst, int ldd, int dn0, int dk0, float* tile, bool rperm = false) {
  const int tid = threadIdx.x;
#pragma unroll
  for (int i = 0; i < 8; ++i) { int e = tid + i * 512, kk = e >> 6, nn = e & 63;
    tile[kk * 65 + nn] = src ? src[(size_t)(k0 + kk) * lds_ + n0 + nn] : 0.f; }
  __syncthreads();
#pragma unroll
  for (int i = 0; i < 8; ++i) { int e = tid + i * 512, nn = e >> 6, kk = e & 63;
    dst[(size_t)(dn0 + (rperm ? rope_phys(nn) : nn)) * ldd + dk0 + kk] = f2bf(tile[kk * 65 + nn]); }
  __syncthreads();
}

__device__ void phase_prep(const Params& p, char* lds) {
  const int tid = threadIdx.x, vb = vblock(), nb = gridDim.x;
  char* ws = p.ws;
  {
    float* s = (float*)lds;
    float* red = s + 9 * 1024;
    bool any = false;
    for (int it = vb; it < 192; it += nb) {
      if (!any) { for (int e = tid; e < 9 * 1024; e += 512) { int r = e >> 10, k = e & 1023; float v = r == 0 ? p.c_ctx[k] : p.c[(r - 1) * 1024 + k]; s[e] = siluf(v); } __syncthreads(); any = true; }
      int l = it / 96, n0 = (it % 96) * 32, col = tid & 31, kg = tid >> 5;
      const float* w = p.w_ada + (size_t)l * 1024 * 3072 + n0 + col;
      float acc[9];
#pragma unroll
      for (int r = 0; r < 9; ++r) acc[r] = 0.f;
#pragma unroll 16
      for (int k = kg * 64; k < kg * 64 + 64; ++k) { float wv = w[(size_t)k * 3072];
#pragma unroll
        for (int r = 0; r < 9; ++r) acc[r] += s[r * 1024 + k] * wv; }
#pragma unroll
      for (int r = 0; r < 9; ++r) red[(kg * 9 + r) * 32 + col] = acc[r];
      __syncthreads();
      if (tid < 288) { int r = tid >> 5, c = tid & 31; float v = p.b_ada[l * 3072 + n0 + c];
        for (int g = 0; g < 16; ++g) v += red[(g * 9 + r) * 32 + c];
        ((float*)(ws + WS_MOD))[(l * 9 + r) * 3072 + n0 + c] = v; }
      __syncthreads();
    }
    __syncthreads();
  }
  {
    float* tile = (float*)lds;
    u16* wt1 = (u16*)(ws + WS_WT1); u16* wtq = (u16*)(ws + WS_WTQ); u16* wtv = (u16*)(ws + WS_WTV);
    u16* wto = (u16*)(ws + WS_WTO); u16* wtn = (u16*)(ws + WS_WTN); u16* wtno = (u16*)(ws + WS_WTNO);
    for (int it = vb; it < 2560; it += nb) {
      int i = it;
      if (i < 640) { int c = i >> 4, kt = i & 15; int srcn = c < 32 ? 448 + c * 64 : (c < 36 ? (c - 32) * 64 : (c < 38 ? 256 + (c - 36) * 64 : 384));
        tr_tile(c == 39 ? nullptr : p.w_in, 2496, kt * 64, srcn, wt1, 1024, c * 64, kt * 64, tile); continue; }
      i -= 640;
      if (i < 64) { int h = i >> 2, kt = i & 3; tr_tile(p.w_qb, 3072, kt * 64, h * 192 + 128, wtq, 256, h * 192 + 128, kt * 64, tile, true); continue; }
      i -= 64;
      if (i < 64) { int h = i >> 2, nc = (i >> 1) & 1, kt = i & 1;
        tr_tile(p.w_kvb, 4096, kt * 64, h * 256 + 128 + nc * 64, wtv, 128, h * 128 + nc * 64, kt * 64, tile); continue; }
      i -= 64;
      if (i < 512) { int kt = i >> 4, nc = i & 15; tr_tile(p.w_out, 1024, kt * 64, nc * 64, wto, 2048, nc * 64, kt * 64, tile); continue; }
      i -= 512;
      if (i < 1024) { int kt = i >> 6, nc = i & 63; tr_tile(p.na_w_in, 4096, kt * 64, nc * 64, wtn, 1024, nc * 64, kt * 64, tile); continue; }
      i -= 1024;
      { int kt = i >> 4, nc = i & 15; tr_tile(p.na_w_out, 1024, kt * 64, nc * 64, wtno, 1024, nc * 64, kt * 64, tile); }
    }
  }
  {
    float* Bs = (float*)lds;
    float* As = Bs + 128 * 129;
    u16* wtq = (u16*)(ws + WS_WTQ);
    for (int it = (nb == 256 ? vb - 192 : vb); it >= 0 && it < 128; it += (nb == 256 ? 64 : nb)) {
      int h = it >> 3, kt = it & 7;
      for (int e = tid; e < 128 * 128; e += 512) { int j = e >> 7, d = e & 127; Bs[j * 129 + d] = p.w_kvb[(size_t)j * 4096 + h * 256 + d]; }
      for (int e = tid; e < 32 * 128; e += 512) { int k = e >> 7, d = e & 127; As[k * 128 + d] = p.w_qb[(size_t)(kt * 32 + k) * 3072 + h * 192 + d]; }
      __syncthreads();
      int j = tid & 127, kq = tid >> 7;
      float acc[8];
#pragma unroll
      for (int i = 0; i < 8; ++i) acc[i] = 0.f;
      for (int d = 0; d < 128; ++d) { float b = Bs[j * 129 + d];
#pragma unroll
        for (int i = 0; i < 8; ++i) acc[i] += As[(kq * 8 + i) * 128 + d] * b; }
      u32x4 w = {cvtpk(acc[0], acc[1]), cvtpk(acc[2], acc[3]), cvtpk(acc[4], acc[5]), cvtpk(acc[6], acc[7])};
      *reinterpret_cast<u32x4*>(wtq + (size_t)(h * 192 + j) * 256 + kt * 32 + kq * 8) = w;
      __syncthreads();
    }
  }
  {
    u16* ks = (u16*)(ws + WS_KS);
    const int gt = vb * 512 + tid, gs = nb * 512;
    for (int e = gt; e < 8 * 256 * 192; e += gs) { int c = e % 192, bk = e / 192, b = bk >> 8, key = bk & 255;
      float v = c < 128 ? p.c_ckv[(size_t)bk * 128 + c] : p.c_krope[(size_t)bk * 64 + c - 128];
      ks[((size_t)b * KEYS_S + key) * 192 + (c < 128 ? c : 128 + rope_phys(c - 128))] = f2bf(v); }
    u16* cnk = (u16*)(ws + WS_CNK); u16* cnv = (u16*)(ws + WS_CNV);
    for (int e = gt; e < 8 * 256 * 1024 / 4; e += gs) {
      f32x4 a = reinterpret_cast<const f32x4*>(p.c_nak)[e], b = reinterpret_cast<const f32x4*>(p.c_nav)[e];
      u32x2 wa = {cvtpk(a[0], a[1]), cvtpk(a[2], a[3])}, wb = {cvtpk(b[0], b[1]), cvtpk(b[2], b[3])};
      reinterpret_cast<u32x2*>(cnk)[e] = wa; reinterpret_cast<u32x2*>(cnv)[e] = wb; }
  }
}

__device__ void phase_norm0(const Params& p) {
  const int lane = threadIdx.x & 63, wv = vblock() * 8 + (threadIdx.x >> 6), nw = gridDim.x * 8;
  const float* mod = (const float*)(p.ws + WS_MOD);
  u16* H = (u16*)(p.ws + WS_H);
  for (int t0 = wv * 4; t0 < NTOK; t0 += nw * 4) {
    const float* m = mod + modrow(t0) * 3072;
    f32x4 v[4][4]; float ss[4];
#pragma unroll
    for (int k = 0; k < 4; ++k) { const float* x = xrow(p, t0 + k);
#pragma unroll
      for (int i = 0; i < 4; ++i) v[k][i] = __builtin_nontemporal_load(reinterpret_cast<const f32x4*>(x + i * 256 + lane * 4)); }
#pragma unroll
    for (int k = 0; k < 4; ++k) { float s = 0;
#pragma unroll
      for (int i = 0; i < 4; ++i) s += v[k][i][0] * v[k][i][0] + v[k][i][1] * v[k][i][1] + v[k][i][2] * v[k][i][2] + v[k][i][3] * v[k][i][3];
      ss[k] = s; }
#pragma unroll
    for (int o = 32; o > 0; o >>= 1) {
#pragma unroll
      for (int k = 0; k < 4; ++k) ss[k] += __shfl_xor(ss[k], o); }
    float rstd[4];
#pragma unroll
    for (int k = 0; k < 4; ++k) rstd[k] = rsqrtf(ss[k] * (1.f / 1024.f) + EPSN);
#pragma unroll
    for (int i = 0; i < 4; ++i) { int c = i * 256 + lane * 4;
      f32x4 g = *reinterpret_cast<const f32x4*>(p.pre_g + c), sh = *reinterpret_cast<const f32x4*>(m + c), sc = *reinterpret_cast<const f32x4*>(m + 1024 + c);
      f32x4 gs = {g[0] * (1.f + sc[0]), g[1] * (1.f + sc[1]), g[2] * (1.f + sc[2]), g[3] * (1.f + sc[3])};
#pragma unroll
      for (int k = 0; k < 4; ++k) {
        float o0 = v[k][i][0] * rstd[k] * gs[0] + sh[0], o1 = v[k][i][1] * rstd[k] * gs[1] + sh[1];
        float o2 = v[k][i][2] * rstd[k] * gs[2] + sh[2], o3 = v[k][i][3] * rstd[k] * gs[3] + sh[3];
        u32x2 w = {cvtpk(o0, o1), cvtpk(o2, o3)}; *reinterpret_cast<u32x2*>(H + (size_t)(t0 + k) * 1024 + c) = w; } }
  }
}

__device__ void phase_post1(const Params& p) {
  const int lane = threadIdx.x & 63, wv = vblock() * 8 + (threadIdx.x >> 6), nw = gridDim.x * 8;
  const float* P1 = (const float*)(p.ws + WS_P1);
  u16* QN = (u16*)(p.ws + WS_QN); u16* KS = (u16*)(p.ws + WS_KS); u16* KP = (u16*)(p.ws + WS_KP);
  const f32x4 g = *reinterpret_cast<const f32x4*>(p.qg + lane * 4);
  const float kg0 = p.kvg[lane * 2], kg1 = p.kvg[lane * 2 + 1];
  const float inv = exp2f(-(float)(lane & 15) * (13.287712379549449f / 16.f));
  constexpr int R = 4;
  for (int t0 = wv * R; t0 < NTOK; t0 += nw * R) {
    f32x4 qa[R]; float k0[R], k1[R], kr[R], ss[R], s2[R];
#pragma unroll
    for (int k = 0; k < R; ++k) { const float* r = P1 + (size_t)(t0 + k) * 448;
      qa[k] = *reinterpret_cast<const f32x4*>(r + lane * 4); k0[k] = r[256 + lane * 2]; k1[k] = r[256 + lane * 2 + 1]; kr[k] = r[384 + lane]; }
#pragma unroll
    for (int k = 0; k < R; ++k) { ss[k] = qa[k][0] * qa[k][0] + qa[k][1] * qa[k][1] + qa[k][2] * qa[k][2] + qa[k][3] * qa[k][3]; s2[k] = k0[k] * k0[k] + k1[k] * k1[k]; }
#pragma unroll
    for (int o = 32; o > 0; o >>= 1) {
#pragma unroll
      for (int k = 0; k < R; ++k) { ss[k] += __shfl_xor(ss[k], o); s2[k] += __shfl_xor(s2[k], o); } }
#pragma unroll
    for (int k = 0; k < R; ++k) { const int t = t0 + k;
      float rstd = rsqrtf(ss[k] * (1.f / 256.f) + EPSN), rs2 = rsqrtf(s2[k] * (1.f / 128.f) + EPSN);
      u32x2 w = {cvtpk(qa[k][0] * rstd * g[0], qa[k][1] * rstd * g[1]), cvtpk(qa[k][2] * rstd * g[2], qa[k][3] * rstd * g[3])};
      *reinterpret_cast<u32x2*>(QN + (size_t)t * 256 + lane * 4) = w;
      float c0 = k0[k] * rs2 * kg0, c1 = k1[k] * rs2 * kg1, krv = kr[k];
      u16* kd;
      if (t < NTOK_P) {
        kd = KP + (size_t)t * 192;
        p.out[OUT_CKV + (size_t)t * 128 + lane * 2] = c0; p.out[OUT_CKV + (size_t)t * 128 + lane * 2 + 1] = c1;
        p.out[OUT_KROPE + (size_t)t * 64 + lane] = krv;
      } else {
        int ts = t - NTOK_P, b = ts >> 12, n = ts & 4095;
        kd = KS + ((size_t)b * KEYS_S + 256 + n) * 192;
        float pos = (float)((lane & 32) ? (n & 63) : (n >> 6));
        float ang = pos * inv, cs = __cosf(ang), sn = __sinf(ang);
        float other = __shfl_xor(krv, 16);
        krv = (lane & 16) ? (krv * cs + other * sn) : (krv * cs - other * sn);
      }
      *reinterpret_cast<unsigned*>(kd + lane * 2) = cvtpk(c0, c1);
      kd[128 + rope_phys(lane)] = f2bf(krv); }
  }
}

__device__ void phase_mid(const Params& p) {
  const int lane = threadIdx.x & 63, wv = vblock() * 8 + (threadIdx.x >> 6), nw = gridDim.x * 8;
  const float* mod = (const float*)(p.ws + WS_MOD);
  const u16* OSM = (const u16*)(p.ws + WS_OSM); u16* H1 = (u16*)(p.ws + WS_H1);
  constexpr int R = 2;
  for (int t0 = wv * R; t0 < NTOK; t0 += nw * R) {
    const float* m0 = mod + modrow(t0) * 3072; const float* m1 = mod + (9 + modrow(t0)) * 3072;
    u32x2 wo[R][4]; f32x4 xc[R][4];
#pragma unroll
    for (int k = 0; k < R; ++k) { const float* x = xrow(p, t0 + k);
#pragma unroll
      for (int i = 0; i < 4; ++i) { wo[k][i] = __builtin_nontemporal_load(reinterpret_cast<const u32x2*>(OSM + (size_t)(t0 + k) * 1024 + i * 256 + lane * 4)); xc[k][i] = __builtin_nontemporal_load(reinterpret_cast<const f32x4*>(x + i * 256 + lane * 4)); } }
    float ov[R][16], ss[R];
#pragma unroll
    for (int k = 0; k < R; ++k) { float s = 0;
#pragma unroll
      for (int i = 0; i < 4; ++i) { u32x2 w = wo[k][i];
        ov[k][i * 4 + 0] = __uint_as_float(w[0] << 16); ov[k][i * 4 + 1] = __uint_as_float(w[0] & 0xffff0000u);
        ov[k][i * 4 + 2] = __uint_as_float(w[1] << 16); ov[k][i * 4 + 3] = __uint_as_float(w[1] & 0xffff0000u); }
#pragma unroll
      for (int i = 0; i < 16; ++i) s += ov[k][i] * ov[k][i];
      ss[k] = s; }
#pragma unroll
    for (int o = 32; o > 0; o >>= 1) {
#pragma unroll
      for (int k = 0; k < R; ++k) ss[k] += __shfl_xor(ss[k], o); }
    float rstd[R], s2[R];
#pragma unroll
    for (int k = 0; k < R; ++k) { rstd[k] = rsqrtf(ss[k] * (1.f / 1024.f) + EPSN); s2[k] = 0; }
    float x1[R][16];
#pragma unroll
    for (int i = 0; i < 4; ++i) { int c = i * 256 + lane * 4;
      f32x4 pg = *reinterpret_cast<const f32x4*>(p.post_g + c), gg = *reinterpret_cast<const f32x4*>(m0 + 2048 + c);
#pragma unroll
      for (int k = 0; k < R; ++k) { f32x4 r;
#pragma unroll
        for (int e = 0; e < 4; ++e) { r[e] = xc[k][i][e] + gg[e] * (ov[k][i * 4 + e] * rstd[k] * pg[e]); x1[k][i * 4 + e] = r[e]; s2[k] += r[e] * r[e]; }
        u32x2 wx = {cvtpk(r[0], r[1]), cvtpk(r[2], r[3])};
        *reinterpret_cast<u32x2*>(reinterpret_cast<u16*>(p.out + OUT_Y + (size_t)(t0 + k) * 1024) + c) = wx; } }
#pragma unroll
    for (int o = 32; o > 0; o >>= 1) {
#pragma unroll
      for (int k = 0; k < R; ++k) s2[k] += __shfl_xor(s2[k], o); }
    float rstd1[R];
#pragma unroll
    for (int k = 0; k < R; ++k) rstd1[k] = rsqrtf(s2[k] * (1.f / 1024.f) + EPSN);
#pragma unroll
    for (int i = 0; i < 4; ++i) { int c = i * 256 + lane * 4;
      f32x4 g = *reinterpret_cast<const f32x4*>(p.pre_g + 1024 + c), sh = *reinterpret_cast<const f32x4*>(m1 + c), sc = *reinterpret_cast<const f32x4*>(m1 + 1024 + c);
#pragma unroll
      for (int k = 0; k < R; ++k) { float o[4];
#pragma unroll
        for (int e = 0; e < 4; ++e) o[e] = x1[k][i * 4 + e] * rstd1[k] * g[e] * (1.f + sc[e]) + sh[e];
        u32x2 w = {cvtpk(o[0], o[1]), cvtpk(o[2], o[3])}; *reinterpret_cast<u32x2*>(H1 + (size_t)(t0 + k) * 1024 + c) = w; } }
  }
}

__device__ void phase_final(const Params& p) {
  const int lane = threadIdx.x & 63, wv = vblock() * 8 + (threadIdx.x >> 6), nw = gridDim.x * 8;
  const float* mod = (const float*)(p.ws + WS_MOD);
  const u16* OSM = (const u16*)(p.ws + WS_OSM2);
  constexpr int R = 4;
  for (int t0 = wv * R; t0 < NTOK; t0 += nw * R) {
    const float* m1 = mod + (9 + modrow(t0)) * 3072;
    u32x2 wo[R][4], wx[R][4];
#pragma unroll
    for (int k = 0; k < R; ++k)
#pragma unroll
      for (int i = 0; i < 4; ++i) { wo[k][i] = __builtin_nontemporal_load(reinterpret_cast<const u32x2*>(OSM + (size_t)(t0 + k) * 1024 + i * 256 + lane * 4));
        wx[k][i] = __builtin_nontemporal_load(reinterpret_cast<const u32x2*>(reinterpret_cast<const u16*>(p.out + OUT_Y + (size_t)(t0 + k) * 1024) + i * 256 + lane * 4)); }
    float ss[R];
#pragma unroll
    for (int k = 0; k < R; ++k) { float s = 0;
#pragma unroll
      for (int i = 0; i < 4; ++i) { u32x2 w = wo[k][i]; float a0 = __uint_as_float(w[0] << 16), a1 = __uint_as_float(w[0] & 0xffff0000u), a2 = __uint_as_float(w[1] << 16), a3 = __uint_as_float(w[1] & 0xffff0000u);
        s += a0 * a0 + a1 * a1 + a2 * a2 + a3 * a3; }
      ss[k] = s; }
#pragma unroll
    for (int o = 32; o > 0; o >>= 1) {
#pragma unroll
      for (int k = 0; k < R; ++k) ss[k] += __shfl_xor(ss[k], o); }
    float rstd[R];
#pragma unroll
    for (int k = 0; k < R; ++k) rstd[k] = rsqrtf(ss[k] * (1.f / 1024.f) + EPSN);
    asm volatile("s_waitcnt vmcnt(0)" ::: "memory");
#pragma unroll
    for (int i = 0; i < 4; ++i) { int c = i * 256 + lane * 4;
      f32x4 pg = *reinterpret_cast<const f32x4*>(p.post_g + 1024 + c), gg = *reinterpret_cast<const f32x4*>(m1 + 2048 + c);
#pragma unroll
      for (int k = 0; k < R; ++k) { u32x2 w = wo[k][i], xw = wx[k][i];
        float a0 = __uint_as_float(w[0] << 16), a1 = __uint_as_float(w[0] & 0xffff0000u), a2 = __uint_as_float(w[1] << 16), a3 = __uint_as_float(w[1] & 0xffff0000u);
        float x0 = __uint_as_float(xw[0] << 16), x1_ = __uint_as_float(xw[0] & 0xffff0000u), x2 = __uint_as_float(xw[1] << 16), x3 = __uint_as_float(xw[1] & 0xffff0000u);
        f32x4 r = {x0 + gg[0] * (a0 * rstd[k] * pg[0]), x1_ + gg[1] * (a1 * rstd[k] * pg[1]), x2 + gg[2] * (a2 * rstd[k] * pg[2]), x3 + gg[3] * (a3 * rstd[k] * pg[3])};
        __builtin_nontemporal_store(r, reinterpret_cast<f32x4*>(p.out + OUT_Y + (size_t)(t0 + k) * 1024 + c)); } }
  }
}

template <int VAR>
__device__ void phase_mla_attn(const Params& p, char* lds) {
  const u16* Q = (const u16*)(p.ws + WS_Q); const u16* KS = (const u16*)(p.ws + WS_KS); const u16* KP = (const u16*)(p.ws + WS_KP);
  const u16* WVT = (const u16*)(p.ws + WS_WTV); u16* GT = (u16*)(p.ws + WS_GATE);
  const int nb = gridDim.x, vb = vblock();
  for (int it = vb; it < 2048; it += nb) {
    int per = nb >> 3, xcd = (per > 0 && (nb & 7) == 0) ? vb / per : 0;
    int idx = it;
    if ((nb & 7) == 0 && (256 % per) == 0) { int round = it / nb; int local = vb - xcd * per; idx = xcd * 256 + round * per + local; }
    int b = idx >> 8, h = (idx >> 4) & 15, qt = idx & 15;
    mla_attn_body<VAR>(Q + (size_t)(NTOK_P + b * SEQS + qt * 256) * 3072 + h * 192, KS + (size_t)b * KEYS_S * 192, KEYS_S, lds,
                       WVT + (size_t)h * 128 * 128, GT + (size_t)(NTOK_P + b * SEQS + qt * 256) * 2048 + h * 128);
  }
  for (int it = vb; it < 512; it += nb) {
    int bp = it >> 4, h = it & 15;
    mla_attn_body<VAR>(Q + (size_t)(bp * 256) * 3072 + h * 192, KP + (size_t)bp * 256 * 192, 256, lds,
                       WVT + (size_t)h * 128 * 128, GT + (size_t)(bp * 256) * 2048 + h * 128);
  }
}

__device__ void phase_na_attn(const Params& p, char* lds) {
  const u16* NQ = (const u16*)(p.ws + WS_NQ); const u16* NK = (const u16*)(p.ws + WS_NK); const u16* NV = (const u16*)(p.ws + WS_NV);
  u16* NG = (u16*)(p.ws + WS_NG); const u16* CNK = (const u16*)(p.ws + WS_CNK); const u16* CNV = (const u16*)(p.ws + WS_CNV);
  float* tbl = (float*)(lds + N_OFF_TBL);
  const int nb = gridDim.x, vb = vblock(), tid = threadIdx.x;
  for (int it = vb; it < 2048; it += nb) {
    int per = nb >> 3, xcd = (per > 0 && (nb & 7) == 0) ? vb / per : 0;
    int idx = it;
    if ((nb & 7) == 0 && (256 % per) == 0) { int round = it / nb; int local = vb - xcd * per; idx = xcd * 256 + round * per + local; }
    int b = idx >> 8, h = (idx >> 4) & 15, rq4 = idx & 15, r0 = rq4 * 4;
    for (int e = tid; e < 465; e += 512) tbl[e] = p.na_bias[h * 465 + e] * LOG2E;
    __syncthreads();
    int lo = min(max(r0 - 4, 0), 56), hir = min(max(r0 - 1, 0), 56) + 7, nloc = hir - lo + 1;
    int NT = 4 + ((nloc + 1) & ~1);
    size_t tok0 = (size_t)NTOK_P + (size_t)b * SEQS;
    na_attn_body(NQ + (tok0 + r0 * 64) * 1024 + h * 64, CNK + (size_t)b * 256 * 1024 + h * 64, CNV + (size_t)b * 256 * 1024 + h * 64,
                 NK + tok0 * 1024 + h * 64, NV + tok0 * 1024 + h * 64, 4, NT, lo, true, r0, NG + (tok0 + r0 * 64) * 1024 + h * 64, lds);
  }
  for (int it = vb; it < 512; it += nb) {
    int bp = it >> 4, h = it & 15; size_t o = (size_t)bp * 256 * 1024 + h * 64;
    na_attn_body(NQ + o, NK + o, NV + o, NK + o, NV + o, 4, 4, 0, false, 0, NG + o, lds);
  }
}


#define XB_TMO      128
#define XB_XCNT(j)  (256  + 64 * (j))
#define XB_XSUB(j)  (1280 + 64 * (j))
#define XB_XGEN(j)  (2304 + 64 * (j))
#define XB_TOP      3328
#define XB_TOPGEN   3392
#define XCD_BAR_WORDS 3456
#define XB_SPIN_CAP (1u << 18)
__device__ __forceinline__ unsigned xb_ld(unsigned* p)              { return __hip_atomic_load(p, __ATOMIC_RELAXED, __HIP_MEMORY_SCOPE_AGENT); }
__device__ __forceinline__ unsigned xb_add(unsigned* p, unsigned v) { return __hip_atomic_fetch_add(p, v, __ATOMIC_RELAXED, __HIP_MEMORY_SCOPE_AGENT); }
__device__ __forceinline__ unsigned xb_xcc_id() { return (unsigned)__builtin_amdgcn_s_getreg((3 << 11) | 20) & 0xFu; }
#define XB_SPIN(cond, bar) do { unsigned _sp = 0; while (cond) { __builtin_amdgcn_s_sleep(1); \
    if ((++_sp & 255u) == 0u) { if (xb_ld(&(bar)[XB_TMO])) break; if (_sp > XB_SPIN_CAP) { atomicAdd(&(bar)[XB_TMO], 1u); break; } } } } while (0)
__device__ __forceinline__ void xcd_barrier_complete(unsigned* bar, unsigned x, unsigned& nloc, unsigned& nx) {
  const unsigned G = gridDim.x * gridDim.y * gridDim.z;
  unsigned sum, cnt, mine, sp = 0u;
  for (;;) {
    sum = 0u; cnt = 0u; mine = 0u;
#pragma unroll
    for (unsigned j = 0; j < 16; ++j) { const unsigned c = xb_ld(&bar[XB_XCNT(j)]); sum += c; cnt += (c > 0u) ? 1u : 0u; mine = (j == x) ? c : mine; }
    if (sum == G) break;
    __builtin_amdgcn_s_sleep(1);
    if ((++sp & 255u) == 0u) { if (xb_ld(&bar[XB_TMO])) break; if (sp > XB_SPIN_CAP) { atomicAdd(&bar[XB_TMO], 1u); break; } }
  }
  nloc = mine > 0u ? mine : 1u; nx = cnt > 0u ? cnt : 1u;
}
__device__ __forceinline__ void xcd_barrier(unsigned* bar, volatile LAS unsigned* st) {
  asm volatile("s_waitcnt vmcnt(0)" ::: "memory");
  __syncthreads();
  if (threadIdx.x == 0) {
    const unsigned x = xb_xcc_id();
    __builtin_amdgcn_s_waitcnt(0);
    unsigned nloc = st[0], nx = st[1];
    if (nloc == 0u) { xcd_barrier_complete(bar, x, nloc, nx); st[0] = nloc; st[1] = nx; }
    const unsigned old = xb_add(&bar[XB_XSUB(x)], 1u);
    const unsigned gen = old / nloc;
    if (old + 1u == (gen + 1u) * nloc) {
      __builtin_amdgcn_fence(__ATOMIC_RELEASE, "agent");
      asm volatile("s_waitcnt vmcnt(0)" ::: "memory");
      const unsigned og = xb_add(&bar[XB_TOP], 1u);
      const unsigned tg = og / nx;
      if (og + 1u == (tg + 1u) * nx) xb_add(&bar[XB_TOPGEN], 1u);
      else XB_SPIN(xb_ld(&bar[XB_TOPGEN]) == tg, bar);
      __builtin_amdgcn_fence(__ATOMIC_ACQUIRE, "agent");
      xb_add(&bar[XB_XGEN(x)], 1u);
      asm volatile("s_waitcnt vmcnt(0)" ::: "memory");
    } else {
      XB_SPIN(xb_ld(&bar[XB_XGEN(x)]) == gen, bar);
      __builtin_amdgcn_fence(__ATOMIC_ACQUIRE, "agent");
      asm volatile("s_waitcnt vmcnt(0)" ::: "memory");
    }
  }
  __syncthreads();
}

template <int PHN>
__device__ __forceinline__ void do_phase(const Params& p, char* lds) {
  char* ws = p.ws; LAS unsigned char* l3 = (LAS unsigned char*)lds;
  if constexpr (PHN == 0) phase_prep(p, lds);
  if constexpr (PHN == 1) phase_norm0(p);
  if constexpr (PHN == 2) gemm_phase(l3, GemmDesc{(const u16*)(ws + WS_H), 1024, 0, (const u16*)(ws + WS_WT1), 1024, 1024, 10}, EpiG1{(u16*)(ws + WS_GATE), (float*)(ws + WS_P1)});
  if constexpr (PHN == 3) phase_post1(p);
  if constexpr (PHN == 4) gemm_phase(l3, GemmDesc{(const u16*)(ws + WS_QN), 256, 0, (const u16*)(ws + WS_WTQ), 256, 256, 12}, EpiG2{(u16*)(ws + WS_Q)});
  if constexpr (PHN == 5) phase_mla_attn<0>(p, lds);
  if constexpr (PHN >= 51 && PHN <= 59) phase_mla_attn<PHN - 50>(p, lds);
  if constexpr (PHN == 7) gemm_phase(l3, GemmDesc{(const u16*)(ws + WS_GATE), 2048, 0, (const u16*)(ws + WS_WTO), 2048, 2048, 4}, EpiStore{(u16*)(ws + WS_OSM)});
  if constexpr (PHN == 8) phase_mid(p);
  if constexpr (PHN == 9) gemm_phase(l3, GemmDesc{(const u16*)(ws + WS_H1), 1024, 0, (const u16*)(ws + WS_WTN), 1024, 1024, 16},
                                     EpiG5{(u16*)(ws + WS_NQ), (u16*)(ws + WS_NK), (u16*)(ws + WS_NV), (u16*)(ws + WS_NG), p.out + OUT_NAK, p.out + OUT_NAV});
  if constexpr (PHN == 10) phase_na_attn(p, lds);
  if constexpr (PHN == 11) gemm_phase(l3, GemmDesc{(const u16*)(ws + WS_NG), 1024, 0, (const u16*)(ws + WS_WTNO), 1024, 1024, 4}, EpiStore{(u16*)(ws + WS_OSM2)});
  if constexpr (PHN == 12) phase_final(p);
}
#ifndef PHASE_SEQ
#define PHASE_SEQ X0(0) X(1) X(2) X(3) X(4) X(5) X(7) X(8) X(9) X(10) X(11) L(12)
#endif
__global__ void __launch_bounds__(NTHREADS) fwd_kernel(Params p_arg) {
  extern __shared__ __attribute__((aligned(16))) char lds[];
  const __attribute__((address_space(4))) char* kap = (const __attribute__((address_space(4))) char*)__builtin_amdgcn_kernarg_segment_ptr();
  asm volatile("" : "+s"(kap));
  const Params& p = *(const Params*)(const char*)kap;
#define G1(n) { int g_; asm volatile("s_mov_b32 %0, 1" : "=s"(g_)); if (g_) do_phase<n>(p, lds); }
  unsigned* bar = (unsigned*)(p.ws + WS_BAR);
  volatile LAS unsigned* st = (volatile LAS unsigned*)((LAS char*)lds + LDS_MAIN);
  if (threadIdx.x < 4) st[threadIdx.x] = 0u;
  if (blockIdx.x == 0) { for (int i = threadIdx.x; i < XCD_BAR_WORDS; i += NTHREADS) bar[i] = 0u; }
  __syncthreads();
#define X0(n) G1(n) cg::this_grid().sync(); if (threadIdx.x == 0) (void)xb_add(&bar[XB_XCNT(xb_xcc_id())], 1u);
#define X(n) G1(n) xcd_barrier(bar, st);
#define L(n) G1(n)
  PHASE_SEQ
#undef X0
#undef X
#undef L
#undef G1
}

constexpr int LDS_BYTES = LDS_MAIN + 16;

extern "C" void kernel_launch(void* const* d_in, const int* in_sizes, int n_in, void* d_out, int out_size, void* d_ws, size_t ws_size, hipStream_t stream) {
  static int grid = 0;
  if (grid == 0) {
    if (ws_size < WS_END) { fprintf(stderr, "kernel_launch: workspace too small: %zu < %zu\n", ws_size, (size_t)WS_END); grid = -1; return; }
    if (hipFuncSetAttribute((const void*)fwd_kernel, hipFuncAttributeMaxDynamicSharedMemorySize, LDS_BYTES) != hipSuccess) { fprintf(stderr, "hipFuncSetAttribute failed\n"); grid = -1; return; }
    int dev = 0, cus = 0, per_cu = 0;
    (void)hipGetDevice(&dev); (void)hipDeviceGetAttribute(&cus, hipDeviceAttributeMultiprocessorCount, dev);
    (void)hipOccupancyMaxActiveBlocksPerMultiprocessor(&per_cu, (const void*)fwd_kernel, NTHREADS, LDS_BYTES);
    if (per_cu < 1) { fprintf(stderr, "occupancy query says %d blocks/CU\n", per_cu); per_cu = 1; }
    (void)hipGetLastError();
    grid = cus;
  }
  if (grid < 0) return;
  Params p{};
  p.x_prompt = (const float*)d_in[0]; p.x_sample = (const float*)d_in[1]; p.c_ckv = (const float*)d_in[2]; p.c_krope = (const float*)d_in[3];
  p.c_nak = (const float*)d_in[4]; p.c_nav = (const float*)d_in[5]; p.c = (const float*)d_in[6]; p.c_ctx = (const float*)d_in[7];
  p.w_ada = (const float*)d_in[8]; p.b_ada = (const float*)d_in[9]; p.pre_g = (const float*)d_in[10]; p.post_g = (const float*)d_in[11];
  p.w_in = (const float*)d_in[12]; p.qg = (const float*)d_in[13]; p.w_qb = (const float*)d_in[14]; p.kvg = (const float*)d_in[15];
  p.w_kvb = (const float*)d_in[16]; p.w_out = (const float*)d_in[17]; p.na_w_in = (const float*)d_in[18]; p.na_bias = (const float*)d_in[19];
  p.na_w_out = (const float*)d_in[20]; p.out = (float*)d_out; p.ws = (char*)d_ws;
  void* args[] = {&p};
  hipError_t e = hipLaunchCooperativeKernel((const void*)fwd_kernel, dim3(grid), dim3(NTHREADS), args, LDS_BYTES, stream);
  if (e != hipSuccess) fprintf(stderr, "cooperative launch failed: %s (grid %d)\n", hipGetErrorString(e), grid);
}
```
